# Optimizing an MI355X kernel written in HIP

```python
import jax
import jax.numpy as jnp
from jax import lax
import numpy as np

D_MODEL = 2048
BATCH = 2
SEQ = 8192
DEPTH = 2

GRID_W = 64
CTX_LEN = 256
HEAD_DIM = 64
A_WIDTH = D_MODEL // 4
B_WIDTH = 3 * D_MODEL // 8
C_WIDTH = D_MODEL - A_WIDTH - B_WIDTH
MIX_WIDTH = A_WIDTH + B_WIDTH + C_WIDTH
A_GROUPS = A_WIDTH // HEAD_DIM
B_HEADS = B_WIDTH // HEAD_DIM
C_HEADS = C_WIDTH // HEAD_DIM
CHUNK = 128
DECAY_LORA = 64
ICLR_LORA = 64
GATE_LORA = 128
B_COLS = 3 * B_WIDTH + 2 * DECAY_LORA + 2 * ICLR_LORA + GATE_LORA
IN_COLS = 2 * A_WIDTH + B_COLS + 3 * C_WIDTH
WIN_ROWS = 8
WIN_COLS = 16
D_FF = 4 * D_MODEL
N_MOD = 6
ALPHA = (2 * DEPTH) ** 0.25
BETA = (8 * DEPTH) ** -0.25
ATTN_SCALE = HEAD_DIM ** -0.5
LN_EPS = 1e-5
GN_EPS = 64e-5
NEG_INF = -1e30

kernel_name = "hybrid_gmlp_rwkv7_natten_dit_block"


def layer_norm(x, gain=None, bias=None, eps=LN_EPS):
    xf = x.astype(jnp.float32)
    mu = jnp.mean(xf, axis=-1, keepdims=True)
    var = jnp.mean(jnp.square(xf - mu), axis=-1, keepdims=True)
    y = ((xf - mu) * lax.rsqrt(var + eps)).astype(x.dtype)
    if gain is not None:
        y = y * gain + bias
    return y


def modulation(cvec, w_ada, b_ada):
    m = jnp.matmul(jax.nn.silu(cvec), w_ada) + b_ada
    return jnp.split(m[..., None, :], N_MOD, axis=-1)


def centred_conv3(z, taps):
    zp = jnp.pad(z, ((0, 0), (1, 1), (0, 0)))
    return zp[:, :-2] * taps[0] + zp[:, 1:-1] * taps[1] + zp[:, 2:] * taps[2]


def chunk_gmlp(u, v, w_s, b_s):
    bn, n, _ = u.shape
    u = jax.nn.gelu(u)
    v = layer_norm(jax.nn.gelu(v).reshape(bn, n // CHUNK, CHUNK, A_GROUPS, HEAD_DIM))
    mixed = jnp.einsum('gij,bnjgc->bnigc', w_s, v) + b_s.T[None, None, :, :, None]
    return u * mixed.reshape(bn, n, A_WIDTH)


def rwkv_project(zb, shift, w0, w2, a0, a2, g2, k_k, k_a):
    bn, n, _ = zb.shape
    zb = centred_conv3(zb, shift)
    cuts = [B_WIDTH, 2 * B_WIDTH, 3 * B_WIDTH, 3 * B_WIDTH + 2 * DECAY_LORA,
            3 * B_WIDTH + 2 * DECAY_LORA + 2 * ICLR_LORA]
    r, k, v, wd, ad, gd = jnp.split(zb, cuts, axis=-1)
    wd = wd.reshape(bn, n, 2, DECAY_LORA)
    ad = ad.reshape(bn, n, 2, ICLR_LORA)
    w_raw = w0[:, None, None, :] + jnp.einsum('bldr,drc->dblc', jnp.tanh(wd), w2)
    w_log = -jax.nn.softplus(-w_raw.astype(jnp.float32)) - 0.5
    decay = jnp.exp(-jnp.exp(w_log))
    a = jax.nn.sigmoid(a0[:, None, None, :] + jnp.einsum('bldr,drc->dblc', ad, a2))
    heads = lambda t: t.reshape(t.shape[:-1] + (B_HEADS, HEAD_DIM))
    kk = heads(k * k_k).astype(jnp.float32)
    kk = kk * lax.rsqrt(jnp.maximum(jnp.sum(kk * kk, axis=-1, keepdims=True), 1e-12))
    k_dir = k[None] * (1.0 + (a - 1.0) * k_a)
    g = jnp.matmul(jax.nn.sigmoid(gd), g2)
    return (heads(r), heads(decay), heads(k_dir), heads(v), -kk, kk[None] * heads(a), g)


def wkv_scan(r, w, k, v, a, b, s0):
    def step(s, inp):
        r_t, w_t, k_t, v_t, a_t, b_t = inp
        sa = jnp.einsum('dbhvk,dbhk->dbhv', s, a_t)
        s = s * w_t[..., None, :] + sa[..., :, None] * b_t[..., None, :] + v_t[..., :, None] * k_t[..., None, :]
        return s, jnp.einsum('dbhvk,dbhk->dbhv', s, r_t)
    s_final, y = lax.scan(step, s0, (r, w, k, v, a, b))
    return y, s_final


def bidir_wkv(r, w, k, v, a, b, s0):
    def time_major(t):
        t = jnp.stack([t[0], jnp.flip(t[1], axis=1)])
        return jnp.moveaxis(t, 2, 0).astype(jnp.float32)
    both = lambda t: jnp.broadcast_to(t, (2,) + t.shape)
    y, s_final = wkv_scan(time_major(both(r)), time_major(w), time_major(k),
                          time_major(both(v)), time_major(both(a)), time_major(b), s0)
    y = jnp.moveaxis(y, 0, 2)
    return y[0] + jnp.flip(y[1], axis=1), s_final


def rwkv_out(y, r, k_dir, v, g, r_k, gn_g, gn_b):
    bn, n = g.shape[:2]
    mu = jnp.mean(y, axis=-1, keepdims=True)
    var = jnp.mean(jnp.square(y - mu), axis=-1, keepdims=True)
    yn = ((y - mu) * lax.rsqrt(var + GN_EPS)).astype(g.dtype).reshape(bn, n, B_WIDTH) * gn_g + gn_b
    bonus = jnp.sum(r * jnp.sum(k_dir, axis=0) * r_k, axis=-1, keepdims=True) * v
    return (yn + bonus.reshape(bn, n, B_WIDTH).astype(g.dtype)) * g


def rwkv_mixer(zb_lat, zb_ctx, shift, w0, w2, a0, a2, g2, k_k, k_a, r_k, gn_g, gn_b, ctx_out):
    pc = rwkv_project(zb_ctx, shift, w0, w2, a0, a2, g2, k_k, k_a)
    pl = rwkv_project(zb_lat, shift, w0, w2, a0, a2, g2, k_k, k_a)
    s0 = jnp.zeros((2, zb_ctx.shape[0], B_HEADS, HEAD_DIM, HEAD_DIM), jnp.float32)
    y_c, s_ctx = bidir_wkv(*pc[:6], s0)
    y_l, _ = bidir_wkv(*pl[:6], s_ctx)
    out_l = rwkv_out(y_l, pl[0], pl[2], pl[3], pl[6], r_k, gn_g, gn_b)
    out_c = rwkv_out(y_c, pc[0], pc[2], pc[3], pc[6], r_k, gn_g, gn_b) if ctx_out else None
    return out_l, out_c


def neighbourhood_attention(q, k, v, k_ctx, v_ctx, rpb):
    bn, t, h, d = q.shape
    rows = t // GRID_W
    kr = min(WIN_ROWS, rows)
    ri = np.arange(rows)
    row_idx = np.clip(ri - kr // 2, 0, rows - kr)[:, None] + np.arange(kr)[None, :]
    ci = np.arange(GRID_W)
    col_start = np.clip(ci - WIN_COLS // 2, 0, GRID_W - WIN_COLS)
    col_in = (ci[None, :] >= col_start[:, None]) & (ci[None, :] < col_start[:, None] + WIN_COLS)
    dr = row_idx - ri[:, None] + WIN_ROWS - 1
    dc = np.clip(ci[None, :] - ci[:, None] + WIN_COLS - 1, 0, 2 * WIN_COLS - 2)
    bias = rpb[:, dr[:, None, :, None], dc[None, :, None, :]].astype(jnp.float32)
    bias = jnp.where(col_in[None, None, :, None, :], bias, NEG_INF)
    qg = (q * ATTN_SCALE).reshape(bn, rows, GRID_W, h, d)
    kb = k.reshape(bn, rows, GRID_W, h, d)[:, row_idx]
    vb = v.reshape(bn, rows, GRID_W, h, d)[:, row_idx]
    s_loc = jnp.einsum('brihd,brjchd->bhrijc', qg, kb).astype(jnp.float32) + bias
    s_ctx = jnp.einsum('brihd,bnhd->bhrin', qg, k_ctx).astype(jnp.float32)
    m = jnp.maximum(jnp.max(s_loc, axis=(-2, -1)), jnp.max(s_ctx, axis=-1))
    e_loc = jnp.exp(s_loc - m[..., None, None])
    e_ctx = jnp.exp(s_ctx - m[..., None])
    denom = jnp.sum(e_loc, axis=(-2, -1)) + jnp.sum(e_ctx, axis=-1)
    o = (jnp.einsum('bhrijc,brjchd->brihd', e_loc.astype(v.dtype), vb)
         + jnp.einsum('bhrin,bnhd->brihd', e_ctx.astype(v.dtype), v_ctx))
    o = (o.astype(jnp.float32) / jnp.moveaxis(denom, 1, -1)[..., None]).astype(v.dtype)
    return o.reshape(bn, t, h * d)


def context_attention(q, k, v):
    bn, n, h, d = q.shape
    s = jnp.einsum('bnhd,bmhd->bhnm', q * ATTN_SCALE, k).astype(jnp.float32)
    p = jax.nn.softmax(s, axis=-1).astype(v.dtype)
    return jnp.einsum('bhnm,bmhd->bnhd', p, v).reshape(bn, n, h * d)


def na_mixer(zc_lat, zc_ctx, rpb, ctx_out):
    heads = lambda t: t.reshape(t.shape[:-1] + (C_HEADS, HEAD_DIM))
    ql, kl, vl = [heads(t) for t in jnp.split(zc_lat, 3, axis=-1)]
    qc, kc, vc = [heads(t) for t in jnp.split(zc_ctx, 3, axis=-1)]
    out_l = neighbourhood_attention(ql, kl, vl, kc, vc, rpb)
    out_c = context_attention(qc, kc, vc) if ctx_out else None
    return out_l, out_c


def sq_relu_mlp(h, w_up, w_down):
    return jnp.matmul(jnp.square(jax.nn.relu(jnp.matmul(h, w_up))), w_down)


def setup_inputs(seed: int = 0) -> dict:
    key = jax.random.key(seed)
    ks = jax.random.split(key, 32)
    f32 = jnp.float32

    def nrm(i, shape, scale):
        return jax.random.normal(ks[i], shape, f32) * scale

    L = DEPTH
    taps = jnp.array([0.25, 0.5, 0.25], f32)[None, :, None]
    return {
        "x": nrm(0, (BATCH, SEQ, D_MODEL), 1.0),
        "c": nrm(1, (BATCH, D_MODEL), 1.0),
        "ctx": nrm(2, (BATCH, CTX_LEN, D_MODEL), 1.0),
        "c_ctx": nrm(3, (D_MODEL,), 1.0),
        "ada_w": nrm(4, (L, D_MODEL, N_MOD * D_MODEL), 0.5 * D_MODEL ** -0.5),
        "ada_b": nrm(5, (L, N_MOD * D_MODEL), 0.01),
        "w_in": nrm(6, (L, D_MODEL, IN_COLS), D_MODEL ** -0.5),
        "gm_ws": nrm(7, (L, A_GROUPS, CHUNK, CHUNK), CHUNK ** -0.5),
        "gm_bs": 1.0 + nrm(8, (L, A_GROUPS, CHUNK), 0.1),
        "rw_shift": taps + nrm(9, (L, 3, B_COLS), 0.05),
        "rw_w0": jax.random.uniform(ks[10], (L, 2, B_WIDTH), f32, -4.0, 1.0),
        "rw_w2": nrm(11, (L, 2, DECAY_LORA, B_WIDTH), DECAY_LORA ** -0.5),
        "rw_a0": nrm(12, (L, 2, B_WIDTH), 0.5),
        "rw_a2": nrm(13, (L, 2, ICLR_LORA, B_WIDTH), ICLR_LORA ** -0.5),
        "rw_g2": nrm(14, (L, GATE_LORA, B_WIDTH), GATE_LORA ** -0.5),
        "rw_kk": 0.85 + nrm(15, (L, B_WIDTH), 0.1),
        "rw_ka": 1.0 + nrm(16, (L, B_WIDTH), 0.1),
        "rw_rk": nrm(17, (L, B_HEADS, HEAD_DIM), 0.1),
        "rw_gn_g": 1.0 + nrm(18, (L, B_WIDTH), 0.1),
        "rw_gn_b": nrm(19, (L, B_WIDTH), 0.02),
        "na_rpb": nrm(20, (L, C_HEADS, 2 * WIN_ROWS - 1, 2 * WIN_COLS - 1), 0.1),
        "w_out": nrm(21, (L, MIX_WIDTH, D_MODEL), BETA * MIX_WIDTH ** -0.5),
        "ln1_g": 1.0 + nrm(22, (L, D_MODEL), 0.1),
        "ln1_b": nrm(23, (L, D_MODEL), 0.02),
        "w_up": nrm(24, (L, D_MODEL, D_FF), D_MODEL ** -0.5),
        "w_down": nrm(25, (L, D_FF, D_MODEL), BETA * D_FF ** -0.5),
        "ln2_g": 1.0 + nrm(26, (L, D_MODEL), 0.1),
        "ln2_b": nrm(27, (L, D_MODEL), 0.02),
    }


def reference(x, c, ctx, c_ctx, ada_w, ada_b, w_in, gm_ws, gm_bs, rw_shift, rw_w0, rw_w2,
              rw_a0, rw_a2, rw_g2, rw_kk, rw_ka, rw_rk, rw_gn_g, rw_gn_b, na_rpb, w_out,
              ln1_g, ln1_b, w_up, w_down, ln2_g, ln2_b):
    xl, xc = x, ctx
    b0 = 2 * A_WIDTH
    c0 = b0 + B_COLS
    for l in range(DEPTH):
        ctx_out = l < DEPTH - 1
        sh1, sc1, g1, sh2, sc2, g2 = modulation(c, ada_w[l], ada_b[l])
        csh1, csc1, cg1, csh2, csc2, cg2 = modulation(c_ctx, ada_w[l], ada_b[l])
        zl = jnp.matmul(xl * (1.0 + sc1) + sh1, w_in[l])
        zc = jnp.matmul(xc * (1.0 + csc1) + csh1, w_in[l])
        ya_l = chunk_gmlp(zl[..., :A_WIDTH], zl[..., A_WIDTH:b0], gm_ws[l], gm_bs[l])
        yb_l, yb_c = rwkv_mixer(zl[..., b0:c0], zc[..., b0:c0], rw_shift[l], rw_w0[l], rw_w2[l],
                                rw_a0[l], rw_a2[l], rw_g2[l], rw_kk[l], rw_ka[l], rw_rk[l],
                                rw_gn_g[l], rw_gn_b[l], ctx_out)
        yc_l, yc_c = na_mixer(zl[..., c0:], zc[..., c0:], na_rpb[l], ctx_out)
        mix_l = jnp.matmul(jnp.concatenate([ya_l, yb_l, yc_l], axis=-1), w_out[l])
        xl = layer_norm(ALPHA * xl + g1 * mix_l, ln1_g[l], ln1_b[l])
        xl = layer_norm(ALPHA * xl + g2 * sq_relu_mlp(xl * (1.0 + sc2) + sh2, w_up[l], w_down[l]),
                        ln2_g[l], ln2_b[l])
        if ctx_out:
            ya_c = chunk_gmlp(zc[..., :A_WIDTH], zc[..., A_WIDTH:b0], gm_ws[l], gm_bs[l])
            mix_c = jnp.matmul(jnp.concatenate([ya_c, yb_c, yc_c], axis=-1), w_out[l])
            xc = layer_norm(ALPHA * xc + cg1 * mix_c, ln1_g[l], ln1_b[l])
            xc = layer_norm(ALPHA * xc + cg2 * sq_relu_mlp(xc * (1.0 + csc2) + csh2, w_up[l], w_down[l]),
                            ln2_g[l], ln2_b[l])
    return xl
```

```cpp
#include <hip/hip_runtime.h>
#include <hip/hip_cooperative_groups.h>
#include <cstdio>
#include <cstdint>
namespace cg = cooperative_groups;

namespace pg8 {
#define PG8_LAS __attribute__((address_space(3)))
typedef unsigned short bf16_t;
typedef short bf16x8 __attribute__((ext_vector_type(8)));
typedef float f32x4 __attribute__((ext_vector_type(4)));
typedef unsigned u32x4 __attribute__((ext_vector_type(4)));
constexpr int BM = 256, BK = 64, HALF = 128, HTB = HALF * BK * 2  , STAGE_BYTES = 8 * HTB, NXCD = 8, WGM = 8;

__host__ __device__ __forceinline__ int lds_byte(int r, int c) { const int st = (r >> 4) * 2 + (c >> 5), rr = r & 15, cc = c & 31, ob = rr * 64 + cc * 2; return st * 1024 + (ob ^ (((ob >> 9) & 1) << 5)); }
__host__ __device__ __forceinline__ void stage_rc(int b, int& R, int& C) { const int st = b / 1024, sb = b % 1024, swz = sb ^ (((sb >> 9) & 1) << 5); R = (st >> 1) * 16 + swz / 64; C = (st & 1) * 32 + (swz % 64) / 2; }
__host__ __device__ __forceinline__ int perm32(int rho) { const int n = rho >> 4, i = rho & 15; return 8 * (i >> 2) + 4 * n + (i & 3); }

struct Unit { int pm, pn, ks; };
struct Gemm { const bf16_t* A; const bf16_t* Bt; int M, N, K; int ld = 0; };

struct StaticOrder {
    int nM, nN, nwg, G, c, wgm;
    __host__ __device__ void init(int M, int N, int G_, int c_, int wgm_ = WGM) { nM = M / BM; nN = N / BM; nwg = nM * nN; G = G_; c = c_; wgm = wgm_; }
    __host__ __device__ bool next(int i, Unit& u) const {
        const long L = (long)i * G + c; if (L >= nwg) return false;
        int wgid = (int)L; { const int q = nwg / NXCD, r = nwg % NXCD, xcd = wgid % NXCD, off = wgid / NXCD; wgid = (xcd < r ? xcd * (q + 1) : r * (q + 1) + (xcd - r) * q) + off; }
        const int nig = wgm * nN, gid = wgid / nig, fm = gid * wgm, gsz = (nM - fm) < wgm ? (nM - fm) : wgm;
        u.pm = fm + ((wgid % nig) % gsz); u.pn = (wgid % nig) / gsz; u.ks = 0; return true;
    }
    __device__ __forceinline__ void a_ready(const Unit&) const {}
    __device__ __forceinline__ void done(const Unit&) const {}
};

__device__ __forceinline__ unsigned cvt_pk_bf16(float lo, float hi) { unsigned r; asm volatile("v_cvt_pk_bf16_f32 %0, %1, %2" : "=v"(r) : "v"(lo), "v"(hi)); return r; }
typedef float f32x2 __attribute__((ext_vector_type(2)));
__device__ __forceinline__ f32x2 gelu_pk(f32x2 v) {
    const f32x2 av = __builtin_elementwise_abs(v), d = av * 0.2316418882f + 1.0f;
    f32x2 t; t.x = __builtin_amdgcn_rcpf(d.x); t.y = __builtin_amdgcn_rcpf(d.y);
    f32x2 q = t * 0.5307027145f + (-0.7265760135f); q = q * t + 0.7107068705f; q = q * t + (-0.142248368f); q = q * t + 0.127414796f; q = q * t;
    const f32x2 s = (v * v) * (-0.72134752044f);
    f32x2 e; e.x = __builtin_amdgcn_exp2f(s.x); e.y = __builtin_amdgcn_exp2f(s.y);
    const f32x2 m = v * (q * e), r = v - m;
    f32x2 o; o.x = v.x < 0.f ? m.x : r.x; o.y = v.y < 0.f ? m.y : r.y; return o;
}

template <int ACT  > struct EpiBf16 {
    static constexpr bool PERM = true, AFTER_DRAIN = false; static_assert(ACT == 0 || ACT == 1, "EpiBf16: ACT is 0 (none) or 1 (gelu_pk)");
    bf16_t* O; int ldc; const float* bias; int split_cols; size_t split_stride; float scale0;
    __device__ __forceinline__ void operator()(const f32x4 (&acc)[2][2][4][2], const Unit& u, int wr, int wc, int fr, int fq) const {
        const int row0 = u.pm * BM + wr * 64 + fr; int colt = u.pn * BM; bf16_t* base = O;
        float sc = 1.f; if (split_cols) { const int t = colt / split_cols; base += (size_t)t * split_stride; colt -= t * split_cols; if (t == 0) sc = scale0; }
        const int col0 = colt + wc * 32 + 8 * fq, bcol0 = u.pn * BM + wc * 32 + 8 * fq;
        f32x4 bv[2][2];
#pragma unroll
        for (int bj = 0; bj < 2; ++bj)
#pragma unroll
            for (int n = 0; n < 2; ++n) bv[bj][n] = bias ? *(const f32x4*)(bias + bcol0 + bj * HALF + 4 * n) : (f32x4){0.f, 0.f, 0.f, 0.f};
#pragma unroll
        for (int ai = 0; ai < 2; ++ai)
#pragma unroll
            for (int m = 0; m < 4; ++m) { bf16_t* rowp = base + (size_t)(row0 + ai * HALF + m * 16) * ldc + col0;
#pragma unroll
                for (int bj = 0; bj < 2; ++bj) { f32x4 v0 = acc[ai][bj][m][0] + bv[bj][0], v1 = acc[ai][bj][m][1] + bv[bj][1];
                    if (ACT == 1) { f32x2 a = gelu_pk((f32x2){v0[0], v0[1]}), b = gelu_pk((f32x2){v0[2], v0[3]}), c = gelu_pk((f32x2){v1[0], v1[1]}), d = gelu_pk((f32x2){v1[2], v1[3]});
                        v0 = (f32x4){a.x, a.y, b.x, b.y}; v1 = (f32x4){c.x, c.y, d.x, d.y}; }
                    v0 = v0 * sc; v1 = v1 * sc; u32x4 w; w.x = cvt_pk_bf16(v0[0], v0[1]); w.y = cvt_pk_bf16(v0[2], v0[3]); w.z = cvt_pk_bf16(v1[0], v1[1]); w.w = cvt_pk_bf16(v1[2], v1[3]);
                    *(u32x4*)(rowp + bj * HALF) = w; } }
    }
};

template <class Epi, class Sched, bool ALIGN_EPI = false, bool SP2 = false>
__device__ __forceinline__ void gemm_phase(PG8_LAS unsigned char* lds, const Gemm g, const Sched& S, const Epi& E) {
    const int tid = threadIdx.x, wid = __builtin_amdgcn_readfirstlane(tid >> 6), lane = tid & 63, wr = wid >> 2, wc = wid & 3, fr = lane & 15, fq = lane >> 4;
    const int K = g.K, nt = K / BK, LD = g.ld ? g.ld : g.K;
    unsigned voffA[2], voffB[2];
#pragma unroll
    for (int i = 0; i < 2; ++i) { int R, C; stage_rc(tid * 16 + i * 8192, R, C); const int Rb = Epi::PERM ? ((R & ~31) + perm32(R & 31)) : R;
        voffA[i] = (unsigned)(R * LD + C) * 2u; voffB[i] = (unsigned)(Rb * LD + C) * 2u; }
    const size_t kstep = (size_t)(BK * 2);
    const size_t hstep = (size_t)HALF * LD * 2;
    const size_t tstep = 2 * hstep;
    const unsigned ldsw = (unsigned)wid * 1024u;
    const int aoff = lds_byte(wr * 64 + fr, fq * 8), boff = lds_byte(wc * 32 + fr, fq * 8);
#define PG8_SA(b, h) (((b) * 2 + (h)) * HTB)
#define PG8_SB(b, h) ((4 + (b) * 2 + (h)) * HTB)
#define PG8_STAGE(bufoff, gbase, voff) do { _Pragma("unroll") for (int _i = 0; _i < 2; ++_i) \
        __builtin_amdgcn_global_load_lds((const unsigned*)((const char*)(gbase) + (voff)[_i]), (PG8_LAS unsigned*)(lds + (bufoff) + ldsw + _i * 8192), 16, 0, 0); } while (0)
#define PG8_LDA(dst, b, h) do { _Pragma("unroll") for (int m = 0; m < 4; ++m) _Pragma("unroll") for (int k = 0; k < 2; ++k) dst[m][k] = *(const PG8_LAS bf16x8*)(lds + PG8_SA(b, h) + aoff + m * 2048 + k * 1024); } while (0)
#define PG8_LDB(dst, b, h) do { _Pragma("unroll") for (int n = 0; n < 2; ++n) _Pragma("unroll") for (int k = 0; k < 2; ++k) dst[n][k] = *(const PG8_LAS bf16x8*)(lds + PG8_SB(b, h) + boff + n * 2048 + k * 1024); } while (0)
#define PG8_MMA(ai, bj, At, Bt) do { __builtin_amdgcn_s_setprio(1); _Pragma("unroll") for (int m = 0; m < 4; ++m) _Pragma("unroll") for (int n = 0; n < 2; ++n) _Pragma("unroll") for (int k = 0; k < 2; ++k) \
        acc[ai][bj][m][n] = __builtin_amdgcn_mfma_f32_16x16x32_bf16(Bt[n][k], At[m][k], acc[ai][bj][m][n], 0, 0, 0); __builtin_amdgcn_s_setprio(0); } while (0)
#define PG8_WAIT_V(n) asm volatile("s_waitcnt vmcnt(" #n ")" ::: "memory")
#define PG8_WAIT_L(n) asm volatile("s_waitcnt lgkmcnt(" #n ")" ::: "memory")
#define PG8_BAR __builtin_amdgcn_s_barrier()
#define PG8_SCHED __builtin_amdgcn_sched_barrier(0)
    Unit cur, nxt; int ui = 0;
    if (!S.next(0, cur)) return;
    f32x4 acc[2][2][4][2];
#pragma unroll
    for (int a = 0; a < 2; ++a)
#pragma unroll
        for (int b = 0; b < 2; ++b)
#pragma unroll
            for (int m = 0; m < 4; ++m)
#pragma unroll
                for (int n = 0; n < 2; ++n) acc[a][b][m][n] = (f32x4){0.f, 0.f, 0.f, 0.f};
    bf16x8 At[4][2], B0[2][2], B1[2][2];
    const char* cA = (const char*)g.A + (size_t)cur.pm * tstep + (size_t)cur.ks * K * 2; const char* cB = (const char*)g.Bt + (size_t)cur.pn * tstep + (size_t)cur.ks * K * 2;
    S.a_ready(cur);
    if constexpr (SP2) {
        PG8_STAGE(PG8_SB(0, 0), cB, voffB); PG8_STAGE(PG8_SB(0, 1), cB + hstep, voffB); PG8_STAGE(PG8_SA(0, 0), cA, voffA); PG8_STAGE(PG8_SA(0, 1), cA + hstep, voffA);
        if (wr == 1) PG8_BAR;
        PG8_WAIT_V(2); PG8_BAR;
        PG8_STAGE(PG8_SB(1, 0), cB + kstep, voffB); PG8_STAGE(PG8_SA(1, 0), cA + kstep, voffA); PG8_STAGE(PG8_SB(1, 1), cB + hstep + kstep, voffB);
        PG8_WAIT_V(6); PG8_BAR;
    } else {
        PG8_STAGE(PG8_SB(0, 0), cB, voffB); PG8_STAGE(PG8_SA(0, 0), cA, voffA); PG8_STAGE(PG8_SB(0, 1), cB + hstep, voffB); PG8_STAGE(PG8_SA(0, 1), cA + hstep, voffA);
        if (wr == 1) PG8_BAR;
        PG8_WAIT_V(4); PG8_BAR;
        PG8_STAGE(PG8_SB(1, 0), cB + kstep, voffB); PG8_STAGE(PG8_SA(1, 0), cA + kstep, voffA); PG8_STAGE(PG8_SB(1, 1), cB + hstep + kstep, voffB);
        PG8_WAIT_V(6); PG8_BAR;
    }
    for (;;) {
        const bool has_next = S.next(ui + 1, nxt);
        const char* nA = has_next ? (const char*)g.A + (size_t)nxt.pm * tstep + (size_t)nxt.ks * K * 2 : cA; const char* nB = has_next ? (const char*)g.Bt + (size_t)nxt.pn * tstep + (size_t)nxt.ks * K * 2 : cB;
        for (int t = 0; t < nt; t += 2) {
            const bool last = (t == nt - 2);
            const char* a1 = cA + (size_t)(t + 1) * kstep;
            const char* a2 = last ? nA : cA + (size_t)(t + 2) * kstep; const char* b2 = last ? nB : cB + (size_t)(t + 2) * kstep;
            const char* a3 = a2 + kstep; const char* b3 = b2 + kstep;
            if (last && has_next) S.a_ready(nxt);
            if constexpr (SP2) {
            PG8_LDB(B0, 0, 0); PG8_LDB(B1, 0, 1); PG8_SCHED; PG8_LDA(At, 0, 0); PG8_STAGE(PG8_SA(1, 1), a1 + hstep, voffA);
            PG8_WAIT_V(8); PG8_WAIT_L(0); PG8_BAR; PG8_MMA(0, 0, At, B0); PG8_MMA(0, 1, At, B1); PG8_BAR; PG8_SCHED;
            PG8_LDA(At, 0, 1); PG8_STAGE(PG8_SB(0, 0), b2, voffB); PG8_STAGE(PG8_SB(0, 1), b2 + hstep, voffB); PG8_STAGE(PG8_SA(0, 0), a2, voffA);
            PG8_WAIT_V(8); PG8_WAIT_L(0); PG8_BAR; PG8_MMA(1, 0, At, B0); PG8_MMA(1, 1, At, B1); PG8_BAR; PG8_SCHED;
            PG8_LDB(B0, 1, 0); PG8_LDB(B1, 1, 1); PG8_SCHED; PG8_LDA(At, 1, 0); PG8_STAGE(PG8_SA(0, 1), a2 + hstep, voffA);
            PG8_WAIT_V(8); PG8_WAIT_L(0); PG8_BAR; PG8_MMA(0, 0, At, B0); PG8_MMA(0, 1, At, B1); PG8_BAR; PG8_SCHED;
            PG8_LDA(At, 1, 1); PG8_STAGE(PG8_SB(1, 0), b3, voffB); PG8_STAGE(PG8_SB(1, 1), b3 + hstep, voffB); PG8_STAGE(PG8_SA(1, 0), a3, voffA);
            PG8_WAIT_V(8); PG8_WAIT_L(0); PG8_BAR; PG8_MMA(1, 0, At, B0); PG8_MMA(1, 1, At, B1); PG8_BAR; PG8_SCHED;
            } else {
            PG8_LDB(B0, 0, 0); PG8_SCHED; PG8_LDA(At, 0, 0); PG8_STAGE(PG8_SA(1, 1), a1 + hstep, voffA);
            PG8_WAIT_L(8); PG8_BAR; PG8_WAIT_L(0); PG8_MMA(0, 0, At, B0); PG8_BAR; PG8_SCHED;
            PG8_LDB(B1, 0, 1); PG8_STAGE(PG8_SB(0, 0), b2, voffB);
            PG8_BAR; PG8_WAIT_L(0); PG8_MMA(0, 1, At, B1); PG8_BAR;
            PG8_LDA(At, 0, 1); PG8_STAGE(PG8_SA(0, 0), a2, voffA);
            PG8_BAR; PG8_WAIT_L(0); PG8_MMA(1, 0, At, B0); PG8_BAR; PG8_SCHED;
            PG8_STAGE(PG8_SB(0, 1), b2 + hstep, voffB);
            PG8_WAIT_V(6); PG8_BAR; PG8_MMA(1, 1, At, B1); PG8_BAR;
            PG8_LDB(B0, 1, 0); PG8_SCHED; PG8_LDA(At, 1, 0); PG8_STAGE(PG8_SA(0, 1), a2 + hstep, voffA);
            PG8_WAIT_L(8); PG8_BAR; PG8_WAIT_L(0); PG8_MMA(0, 0, At, B0); PG8_BAR; PG8_SCHED;
            PG8_LDB(B1, 1, 1); PG8_STAGE(PG8_SB(1, 0), b3, voffB);
            PG8_BAR; PG8_WAIT_L(0); PG8_MMA(0, 1, At, B1); PG8_BAR;
            PG8_LDA(At, 1, 1); PG8_STAGE(PG8_SA(1, 0), a3, voffA);
            PG8_BAR; PG8_WAIT_L(0); PG8_MMA(1, 0, At, B0); PG8_BAR; PG8_SCHED;
            PG8_STAGE(PG8_SB(1, 1), b3 + hstep, voffB);
            PG8_WAIT_V(6); PG8_BAR; PG8_MMA(1, 1, At, B1); PG8_BAR;
            }
        }
        if constexpr (ALIGN_EPI) { if (wr == 0) PG8_BAR; }
        if constexpr (!Epi::AFTER_DRAIN) { E(acc, cur, wr, wc, fr, fq); S.done(cur); }
        if (!has_next) break;
#pragma unroll
        for (int a = 0; a < 2; ++a)
#pragma unroll
            for (int b = 0; b < 2; ++b)
#pragma unroll
                for (int m = 0; m < 4; ++m)
#pragma unroll
                    for (int n = 0; n < 2; ++n) acc[a][b][m][n] = (f32x4){0.f, 0.f, 0.f, 0.f};
        cur = nxt; cA = nA; cB = nB; ++ui;
        if constexpr (ALIGN_EPI) { if (wr == 1) PG8_BAR; }
    }
    PG8_WAIT_V(0);
    if constexpr (!ALIGN_EPI) { if (wr == 0) PG8_BAR; }
    PG8_BAR;
    if constexpr (Epi::AFTER_DRAIN) { E.fused(acc, cur, wr, wc, fr, fq, lds, wid, lane); S.done(cur); }
#undef PG8_SA
#undef PG8_SB
#undef PG8_STAGE
#undef PG8_LDA
#undef PG8_LDB
#undef PG8_MMA
#undef PG8_WAIT_V
#undef PG8_WAIT_L
#undef PG8_BAR
#undef PG8_SCHED
}
}

#define LAS __attribute__((address_space(3)))
typedef unsigned short bf16;
typedef short bf16x8 __attribute__((ext_vector_type(8)));
typedef float f32x4 __attribute__((ext_vector_type(4)));
typedef unsigned u32x4 __attribute__((ext_vector_type(4)));
typedef unsigned u32x2 __attribute__((ext_vector_type(2)));

constexpr int NWAVES = 8, NTHR = 512;
constexpr int D = 2048, SEQ = 8192, CTXL = 256, ML = 16384, MT = 16896;
constexpr int BW = 768, BCOLS = 2688, INC = 6016, INCP = 6144, ZB0 = 1024, ZC0 = 3712, DFF = 8192, NH = 12, SL = 8448;
constexpr int NMOD = 12288;
constexpr float ALPHA = 1.41421356237f;
constexpr float LN_EPS = 1e-5f, GN_EPS = 64e-5f;

constexpr size_t MiB = 1u << 20;
constexpr size_t WS_CTL = 0, CTL_BYTES = 1 * MiB;
constexpr size_t WS_WIN = 1 * MiB, WS_WOUT = 25 * MiB, WS_WUP = 33 * MiB, WS_WDN = 65 * MiB, WS_SMALL = 97 * MiB;
constexpr size_t WS_XC = 99 * MiB, WS_AC = 103 * MiB, WS_Z = 169 * MiB, WS_SOP = 367 * MiB, WS_Y = 590 * MiB, WS_G = 640 * MiB, WS_BV = 665 * MiB, WS_END = 690 * MiB;
constexpr size_t WS_SLAB = 440 * MiB;
constexpr size_t WS_HM = WS_Z;
constexpr size_t SM_W2T = 0, SM_A2T = 98304, SM_G2T = 196608, SM_GMWS = 294912;
constexpr int LDS_BYTES = 147456;

#define LDS_WAIT() asm volatile("s_waitcnt lgkmcnt(0)" ::: "memory")
__device__ __forceinline__ unsigned f2bf(float f) { unsigned u = __builtin_bit_cast(unsigned, f); return (u + 0x7fffu + ((u >> 16) & 1u)) >> 16; }
__device__ __forceinline__ unsigned pk2(float lo, float hi) { return f2bf(lo) | (f2bf(hi) << 16); }
__device__ __forceinline__ float bflo(unsigned w) { return __builtin_bit_cast(float, w << 16); }
__device__ __forceinline__ float bfhi(unsigned w) { return __builtin_bit_cast(float, w & 0xffff0000u); }
__device__ __forceinline__ float bf1(bf16 h) { return __builtin_bit_cast(float, ((unsigned)h) << 16); }
__device__ __forceinline__ float sigmoid_f(float x) { return __builtin_amdgcn_rcpf(1.f + __expf(-x)); }
__device__ __forceinline__ float silu_f(float x) { return x * __builtin_amdgcn_rcpf(1.f + __expf(-x)); }
__device__ __forceinline__ float tanh_f(float x) { const float e = __expf(2.f * x); return 1.f - 2.f * __builtin_amdgcn_rcpf(e + 1.f); }
__device__ __forceinline__ float gelu_f(float x) { const float y = 0.7978845608f * (x + 0.044715f * x * x * x); return 0.5f * x * (1.f + tanh_f(y)); }
__device__ __forceinline__ float wave_sum(float v) {
#pragma unroll
    for (int o = 1; o < 64; o <<= 1) v += __shfl_xor(v, o);
    return v;
}
template <int CTRL> __device__ __forceinline__ float dpp_mov(float x) { return __builtin_bit_cast(float, __builtin_amdgcn_update_dpp(0, __builtin_bit_cast(int, x), CTRL, 0xf, 0xf, true)); }
__device__ __forceinline__ float allreduce16(float x) {
    x += dpp_mov<0x128>(x); x += dpp_mov<0x124>(x); x += dpp_mov<0x122>(x); x += dpp_mov<0x121>(x); return x;
}
#define MFMA16(a, b, c) __builtin_amdgcn_mfma_f32_16x16x32_bf16((a), (b), (c), 0, 0, 0)

template <int ACT> struct EpiStoreBf16 {
    static constexpr bool PERM = true, AFTER_DRAIN = false;
    bf16* O; int ldc;
    __device__ __forceinline__ void operator()(const pg8::f32x4 (&acc)[2][2][4][2], const pg8::Unit& u, int wr, int wc, int fr, int fq) const {
        const int row0 = u.pm * 256 + wr * 64 + fr, col0 = u.pn * 256 + wc * 32 + 8 * fq;
#pragma unroll
        for (int ai = 0; ai < 2; ++ai)
#pragma unroll
            for (int m = 0; m < 4; ++m) { bf16* rowp = O + (size_t)(row0 + ai * 128 + m * 16) * ldc + col0;
#pragma unroll
                for (int bj = 0; bj < 2; ++bj) { pg8::f32x4 v0 = acc[ai][bj][m][0], v1 = acc[ai][bj][m][1];
                    if (ACT == 1) {
#pragma unroll
                        for (int e = 0; e < 4; ++e) { float a = fmaxf(v0[e], 0.f), b = fmaxf(v1[e], 0.f); v0[e] = a * a; v1[e] = b * b; } }
                    u32x4 w; w.x = pg8::cvt_pk_bf16(v0[0], v0[1]); w.y = pg8::cvt_pk_bf16(v0[2], v0[3]); w.z = pg8::cvt_pk_bf16(v1[0], v1[1]); w.w = pg8::cvt_pk_bf16(v1[2], v1[3]);
                    *(u32x4*)(rowp + bj * 128) = w; } }
    }
};
struct EpiRes {
    static constexpr bool PERM = false, AFTER_DRAIN = false;
    const float* srcL; const float* srcC; float* dstL; float* dstC; const float* gate;
    __device__ __forceinline__ void operator()(const pg8::f32x4 (&acc)[2][2][4][2], const pg8::Unit& u, int wr, int wc, int fr, int fq) const {
        const int R0 = u.pm * 256; const float* src; float* dst; int mv;
        if (R0 < ML) { src = srcL + (size_t)R0 * D; dst = dstL + (size_t)R0 * D; mv = (R0 >= SEQ) ? 1 : 0; }
        else { src = srcC + (size_t)(R0 - ML) * D; dst = dstC + (size_t)(R0 - ML) * D; mv = 2; }
        const int col0 = u.pn * 256 + wc * 32 + 4 * fq; const float* gt = gate + mv * NMOD + col0;
        pg8::f32x4 gv[2][2];
#pragma unroll
        for (int bj = 0; bj < 2; ++bj)
#pragma unroll
            for (int n = 0; n < 2; ++n) gv[bj][n] = *(const pg8::f32x4*)(gt + bj * 128 + n * 16);
#pragma unroll
        for (int ai = 0; ai < 2; ++ai)
#pragma unroll
            for (int m = 0; m < 4; ++m) { const size_t off = (size_t)(wr * 64 + fr + ai * 128 + m * 16) * D + col0;
#pragma unroll
                for (int bj = 0; bj < 2; ++bj)
#pragma unroll
                    for (int n = 0; n < 2; ++n) { const pg8::f32x4 s = *(const pg8::f32x4*)(src + off + bj * 128 + n * 16);
                        *(pg8::f32x4*)(dst + off + bj * 128 + n * 16) = s * ALPHA + gv[bj][n] * acc[ai][bj][m][n]; }
                asm volatile("" ::: "memory"); }
    }
};

struct EpiSlabCtx {
    static constexpr bool PERM = false, AFTER_DRAIN = false;
    float* slab; const float* gate; int ldn;
    __device__ __forceinline__ void operator()(const pg8::f32x4 (&acc)[2][2][4][2], const pg8::Unit& u, int wr, int wc, int fr, int fq) const {
        const int col0 = u.pn * 256 + wc * 32 + 4 * fq;
        float* dst = slab + ((size_t)u.ks * (2 * CTXL) + u.pm * 256) * ldn;
#pragma unroll
        for (int bj = 0; bj < 2; ++bj)
#pragma unroll
            for (int n = 0; n < 2; ++n) { const pg8::f32x4 gv = gate ? *(const pg8::f32x4*)(gate + col0 + bj * 128 + n * 16) : (pg8::f32x4){1.f, 1.f, 1.f, 1.f};
#pragma unroll
                for (int ai = 0; ai < 2; ++ai)
#pragma unroll
                    for (int m = 0; m < 4; ++m) *(pg8::f32x4*)(dst + (size_t)(wr * 64 + fr + ai * 128 + m * 16) * ldn + col0 + bj * 128 + n * 16) = gv * acc[ai][bj][m][n]; }
    }
};
struct SplitKOrder {
    int nM, nN, nS, G, c;
    __device__ __forceinline__ bool next(int i, pg8::Unit& u) const { const int L = i * G + c; if (L >= nM * nN * nS) return false; u.ks = L % nS; const int t = L / nS; u.pm = t % nM; u.pn = t / nM; return true; }
    __device__ __forceinline__ void a_ready(const pg8::Unit&) const {}
    __device__ __forceinline__ void done(const pg8::Unit&) const {}
};

__device__ __forceinline__ void transpose_item(const float* W, int K, int N, bf16* WT, int row_off, LAS float* scr, int item, int lane) {
    const int nblk = N / 32, kb = item / nblk, nb = item % nblk, k0 = 64 * kb, n0 = 32 * nb;
#pragma unroll 8
    for (int i = 0; i < 32; ++i) { const int kk = 2 * i + (lane >> 5); scr[kk * 33 + (lane & 31)] = W[(size_t)(k0 + kk) * N + n0 + (lane & 31)]; }
    LDS_WAIT(); asm volatile("" ::: "memory");
    const int c = lane & 7;
#pragma unroll
    for (int j = 0; j < 4; ++j) { const int n = (lane >> 3) + 8 * j; const LAS float* s = scr + (8 * c) * 33 + n;
        u32x4 o; o.x = pk2(s[0 * 33], s[1 * 33]); o.y = pk2(s[2 * 33], s[3 * 33]); o.z = pk2(s[4 * 33], s[5 * 33]); o.w = pk2(s[6 * 33], s[7 * 33]);
        *(u32x4*)(WT + (size_t)(row_off + n0 + n) * K + k0 + 8 * c) = o; }
    LDS_WAIT(); asm volatile("" ::: "memory");
}
struct In { const float* p[28]; };
__device__ __forceinline__ void convert_weights(const In& in, int l, int part, unsigned char* ws, LAS unsigned char* lds, int gw, int NGW, int wave, int lane) {
    LAS float* scr = (LAS float*)(lds + wave * 16384);
    constexpr int I_IN = 32 * 188, I_OUT = 32 * 64, I_UP = 32 * 256, I_DN = 128 * 64, I_L = 24;
    bf16* small = (bf16*)(ws + WS_SMALL);
    if (part == 0 || part == 2 || part == 3) {
        constexpr int NITEMS = I_IN + 4 * I_L + 2 * I_L;
        if (part != 3) for (int it = gw; it < NITEMS; it += NGW) {
            int r = it;
            if (r < I_IN) { transpose_item(in.p[6] + (size_t)l * D * INC, D, INC, (bf16*)(ws + WS_WIN), 0, scr, r, lane); continue; } r -= I_IN;
            if (r < 2 * I_L) { const int d = r / I_L; transpose_item(in.p[11] + (size_t)(l * 2 + d) * 64 * BW, 64, BW, small + SM_W2T + d * BW * 64, 0, scr, r % I_L, lane); continue; } r -= 2 * I_L;
            if (r < 2 * I_L) { const int d = r / I_L; transpose_item(in.p[13] + (size_t)(l * 2 + d) * 64 * BW, 64, BW, small + SM_A2T + d * BW * 64, 0, scr, r % I_L, lane); continue; } r -= 2 * I_L;
            transpose_item(in.p[14] + (size_t)l * 128 * BW, 128, BW, small + SM_G2T, 0, scr, r, lane);
        }
        if (part == 2) return;
        const int gt = gw * 64 + lane, NT = NGW * 64;
        const float* gm = in.p[7] + (size_t)l * 131072;
        for (int i = gt; i < 131072 / 4; i += NT) { const f32x4 v = *(const f32x4*)(gm + 4 * i); u32x2 o; o.x = pk2(v.x, v.y); o.y = pk2(v.z, v.w); *(u32x2*)(small + SM_GMWS + 4 * i) = o; }
        u32x4* padp = (u32x4*)((bf16*)(ws + WS_WIN) + (size_t)INC * D);
        for (int i = gt; i < 128 * D / 8; i += NT) padp[i] = (u32x4){0u, 0u, 0u, 0u};
    } else {
        constexpr int NITEMS = I_OUT + I_UP + I_DN;
        for (int it = gw; it < NITEMS; it += NGW) {
            int r = it;
            if (r < I_OUT) { transpose_item(in.p[21] + (size_t)l * D * D, D, D, (bf16*)(ws + WS_WOUT), 0, scr, r, lane); continue; } r -= I_OUT;
            if (r < I_UP) { transpose_item(in.p[24] + (size_t)l * D * DFF, D, DFF, (bf16*)(ws + WS_WUP), 0, scr, r, lane); continue; } r -= I_UP;
            transpose_item(in.p[25] + (size_t)l * DFF * D, DFF, D, (bf16*)(ws + WS_WDN), 0, scr, r, lane);
        }
    }
}
__device__ __forceinline__ void mod_gemv(const In& in, float* mod, int gw, int NGW, int lane) {
    for (int it = gw; it < 2 * 48 * 16; it += NGW) {
        const int l = it / 768, r = it % 768, cgi = r >> 4, ks = r & 15;
        const float* W = in.p[4] + (size_t)l * D * NMOD + (size_t)(ks * 128) * NMOD + cgi * 256 + lane * 4;
        const float* c0 = in.p[1] + ks * 128; const float* c1 = in.p[1] + D + ks * 128; const float* c2 = in.p[3] + ks * 128;
        f32x4 a0 = {0.f, 0.f, 0.f, 0.f}, a1 = a0, a2 = a0;
#pragma unroll 8
        for (int k = 0; k < 128; ++k) { const f32x4 w = *(const f32x4*)(W + (size_t)k * NMOD);
            const float s0 = silu_f(c0[k]), s1 = silu_f(c1[k]), s2 = silu_f(c2[k]);
            a0 += w * s0; a1 += w * s1; a2 += w * s2; }
        if (ks == 0) { const f32x4 bv = *(const f32x4*)(in.p[5] + (size_t)l * NMOD + cgi * 256 + lane * 4); a0 += bv; a1 += bv; a2 += bv; }
        float* mo = mod + (size_t)l * 3 * NMOD + cgi * 256 + lane * 4;
#pragma unroll
        for (int e = 0; e < 4; ++e) { atomicAdd(mo + e, a0[e]); atomicAdd(mo + NMOD + e, a1[e]); atomicAdd(mo + 2 * NMOD + e, a2[e]); }
    }
}
__device__ __forceinline__ void rowwise(int gw, int NGW, int lane, int nrows, const float* srcL, const float* srcC, float* dstL, float* dstC,
                                        bool do_ln, const float* lng, const float* lnb, bool do_mod, const float* modl, int shc, int scc, bf16* aout, const float* slab = nullptr, int nslab = 0) {
    f32x4 nv[8];
    if (gw < nrows) { const float* s0_ = (gw < ML) ? srcL + (size_t)gw * D : srcC + (size_t)(gw - ML) * D;
#pragma unroll
        for (int j = 0; j < 8; ++j) nv[j] = *(const f32x4*)(s0_ + lane * 4 + 256 * j); }
    for (int m = gw; m < nrows; m += NGW) {
        float* dst; int mv;
        if (m < ML) { dst = dstL + (size_t)m * D; mv = (m >= SEQ) ? 1 : 0; }
        else { dst = dstC + (size_t)(m - ML) * D; mv = 2; }
        f32x4 v[8];
#pragma unroll
        for (int j = 0; j < 8; ++j) v[j] = nv[j];
        { const int mn = m + NGW;
          if (mn < nrows) { const float* s1_ = (mn < ML) ? srcL + (size_t)mn * D : srcC + (size_t)(mn - ML) * D;
#pragma unroll
              for (int j = 0; j < 8; ++j) nv[j] = *(const f32x4*)(s1_ + lane * 4 + 256 * j); } }
        if (nslab > 0 && m >= ML) {
#pragma unroll
            for (int j = 0; j < 8; ++j) v[j] = v[j] * ALPHA;
            for (int sidx = 0; sidx < nslab; ++sidx) { const float* sp = slab + ((size_t)sidx * (2 * CTXL) + (m - ML)) * D + lane * 4;
#pragma unroll
                for (int j = 0; j < 8; ++j) v[j] += *(const f32x4*)(sp + 256 * j); }
        }
        if (do_ln) {
            float s = 0.f;
#pragma unroll
            for (int j = 0; j < 8; ++j) s += (v[j].x + v[j].y) + (v[j].z + v[j].w);
            const float mean = wave_sum(s) * (1.f / D); float s2 = 0.f;
#pragma unroll
            for (int j = 0; j < 8; ++j) { v[j] = v[j] - mean; s2 += (v[j].x * v[j].x + v[j].y * v[j].y) + (v[j].z * v[j].z + v[j].w * v[j].w); }
            const float rstd = rsqrtf(wave_sum(s2) * (1.f / D) + LN_EPS);
#pragma unroll
            for (int j = 0; j < 8; ++j) { const f32x4 gg = *(const f32x4*)(lng + lane * 4 + 256 * j), bb = *(const f32x4*)(lnb + lane * 4 + 256 * j);
                v[j] = v[j] * rstd * gg + bb; *(f32x4*)(dst + lane * 4 + 256 * j) = v[j]; }
        }
        if (do_mod) {
            const float* sh = modl + mv * NMOD + shc * D; const float* sc = modl + mv * NMOD + scc * D;
#pragma unroll
            for (int j = 0; j < 8; ++j) { const f32x4 s1 = *(const f32x4*)(sc + lane * 4 + 256 * j), h1 = *(const f32x4*)(sh + lane * 4 + 256 * j);
                const f32x4 a = v[j] * (s1 + 1.f) + h1; u32x2 o; o.x = pk2(a.x, a.y); o.y = pk2(a.z, a.w);
                *(u32x2*)(aout + (size_t)m * D + lane * 4 + 256 * j) = o; }
        }
    }
}

__device__ __forceinline__ f32x4 bf4(u32x2 w) { return (f32x4){bflo(w.x), bfhi(w.x), bflo(w.y), bfhi(w.y)}; }
__device__ __forceinline__ void rwkv_proj_phase(const bf16* Z, const float* shift, const float* w0, const float* a0, const float* kkp, const float* kap, const float* rkp,
                                                const bf16* w2T, const bf16* a2T, const bf16* g2T, bf16* SOP, bf16* G, bf16* BV, LAS unsigned char* lds, int tid, int wave, int lane) {
    for (int it = blockIdx.x; it < 132 * 3; it += gridDim.x) {
        int fr = lane & 15, g = lane >> 4;
        asm volatile("" : "+v"(fr), "+v"(g));
        const int tt = it / 3, hg = it % 3;
        const int m = tt * 128 + wave * 16 + fr;
        int b, tpos, len, s;
        if (m < ML) { b = m >> 13; tpos = m & 8191; len = SEQ; s = CTXL + tpos; } else { b = (m - ML) >> 8; tpos = (m - ML) & 255; len = CTXL; s = tpos; }
        const bool hp = tpos > 0, hn = tpos < len - 1;
        const long offm = hp ? -(long)INCP : 0, offp = hn ? (long)INCP : 0; const float fm = hp ? 1.f : 0.f, fn = hn ? 1.f : 0.f;
        const bf16* zr = Z + (size_t)m * INCP + ZB0;
        bf16x8 xf[12];
#pragma unroll
        for (int ks = 0; ks < 12; ++ks) {
            const int col = 2304 + 32 * ks + 8 * g;
            const u32x4 c0 = *(const u32x4*)(zr + col), cm = *(const u32x4*)(zr + offm + col), cp = *(const u32x4*)(zr + offp + col);
            float val[8];
#pragma unroll
            for (int q = 0; q < 2; ++q) { const f32x4 t0 = *(const f32x4*)(shift + col + 4 * q) * fm, t1 = *(const f32x4*)(shift + BCOLS + col + 4 * q), t2 = *(const f32x4*)(shift + 2 * BCOLS + col + 4 * q) * fn;
                const unsigned m0 = q ? cm.z : cm.x, m1 = q ? cm.w : cm.y, z0 = q ? c0.z : c0.x, z1 = q ? c0.w : c0.y, p0 = q ? cp.z : cp.x, p1 = q ? cp.w : cp.y;
                val[4 * q + 0] = t0.x * bflo(m0) + t1.x * bflo(z0) + t2.x * bflo(p0);
                val[4 * q + 1] = t0.y * bfhi(m0) + t1.y * bfhi(z0) + t2.y * bfhi(p0);
                val[4 * q + 2] = t0.z * bflo(m1) + t1.z * bflo(z1) + t2.z * bflo(p1);
                val[4 * q + 3] = t0.w * bfhi(m1) + t1.w * bfhi(z1) + t2.w * bfhi(p1); }
#pragma unroll
            for (int e = 0; e < 8; ++e) { if (ks < 4) val[e] = tanh_f(val[e]); else if (ks >= 8) val[e] = sigmoid_f(val[e]); }
            u32x4 pk; pk.x = pk2(val[0], val[1]); pk.y = pk2(val[2], val[3]); pk.z = pk2(val[4], val[5]); pk.w = pk2(val[6], val[7]);
            xf[ks] = __builtin_bit_cast(bf16x8, pk);
            if (ks & 1) asm volatile("" ::: "memory");
        }
#pragma unroll 1
        for (int hh = 0; hh < 4; ++hh) {
            const int h = hg * 4 + hh;
            asm volatile("" : "+v"(fr), "+v"(g));
            __syncthreads();
            {
#pragma unroll 2
                for (int i = 0; i < 6; ++i) { const int cid = tid + 512 * i, tok = cid / 24, ch = cid % 24, wh = ch >> 3, col = wh * BW + h * 64 + (ch & 7) * 8;
                    const int mm = tt * 128 + tok; int tp, ln; if (mm < ML) { tp = mm & 8191; ln = SEQ; } else { tp = (mm - ML) & 255; ln = CTXL; }
                    const bool hp_ = tp > 0, hn_ = tp < ln - 1; const float fm_ = hp_ ? 1.f : 0.f, fn_ = hn_ ? 1.f : 0.f;
                    const bf16* zz = Z + (size_t)mm * INCP + ZB0 + col;
                    const u32x4 c0 = *(const u32x4*)zz, cm = *(const u32x4*)(zz - (hp_ ? INCP : 0)), cp = *(const u32x4*)(zz + (hn_ ? INCP : 0));
                    float val[8];
#pragma unroll
                    for (int qq = 0; qq < 2; ++qq) { const f32x4 t0 = *(const f32x4*)(shift + col + 4 * qq) * fm_, t1 = *(const f32x4*)(shift + BCOLS + col + 4 * qq), t2 = *(const f32x4*)(shift + 2 * BCOLS + col + 4 * qq) * fn_;
                        const unsigned m0 = qq ? cm.z : cm.x, m1 = qq ? cm.w : cm.y, z0 = qq ? c0.z : c0.x, z1 = qq ? c0.w : c0.y, p0 = qq ? cp.z : cp.x, p1 = qq ? cp.w : cp.y;
                        val[4 * qq + 0] = t0.x * bflo(m0) + t1.x * bflo(z0) + t2.x * bflo(p0);
                        val[4 * qq + 1] = t0.y * bfhi(m0) + t1.y * bfhi(z0) + t2.y * bfhi(p0);
                        val[4 * qq + 2] = t0.z * bflo(m1) + t1.z * bflo(z1) + t2.z * bflo(p1);
                        val[4 * qq + 3] = t0.w * bfhi(m1) + t1.w * bfhi(z1) + t2.w * bfhi(p1); }
                    u32x4 pk; pk.x = pk2(val[0], val[1]); pk.y = pk2(val[2], val[3]); pk.z = pk2(val[4], val[5]); pk.w = pk2(val[6], val[7]);
                    *(LAS u32x4*)(lds + tok * 400 + ch * 16) = pk; }
#pragma unroll
                for (int i = 0; i < 6; ++i) { const int cid = tid + 512 * i;
                    if (i < 4) { const int cc = cid & 1023, dd = cc >> 9, n = (cc >> 3) & 63, c8 = cc & 7; const bf16* src = ((i < 2) ? w2T : a2T) + ((size_t)(dd * BW + h * 64 + n) * 64 + c8 * 8);
                        *(LAS u32x4*)(lds + 51200 + ((i < 2) ? 0 : 18432) + (dd * 64 + n) * 144 + c8 * 16) = *(const u32x4*)src; }
                    else { const int cc = cid - 2048, n = cc >> 4, c8 = cc & 15; *(LAS u32x4*)(lds + 51200 + 36864 + n * 272 + c8 * 16) = *(const u32x4*)(g2T + ((size_t)(h * 64 + n) * 128 + c8 * 8)); } }
            }
            __syncthreads();
            const LAS unsigned char* rkv = lds + (wave * 16 + fr) * 400 + 8 * g;
            f32x4 kc[4]; float ss = 0.f;
#pragma unroll
            for (int nb = 0; nb < 4; ++nb) {
                const int c = h * 64 + nb * 16 + 4 * g;
                kc[nb] = bf4(*(const LAS u32x2*)(rkv + 128 + nb * 32));
                const f32x4 t = kc[nb] * *(const f32x4*)(kkp + c);
                ss += (t.x * t.x + t.y * t.y) + (t.z * t.z + t.w * t.w);
            }
            ss += __shfl_xor(ss, 16); ss += __shfl_xor(ss, 32);
            const float inv = rsqrtf(fmaxf(ss, 1e-12f));
            bf16* sp = SOP + ((size_t)((b * NH + h) * SL + s)) * 576 + 4 * g;
            float bon = 0.f;
#pragma unroll
            for (int nb = 0; nb < 4; ++nb) {
                const int n = h * 64 + nb * 16 + fr;
                f32x4 accw[2], acca[2], accg = (f32x4){0.f, 0.f, 0.f, 0.f};
#pragma unroll
                for (int d = 0; d < 2; ++d) { accw[d] = (f32x4){0.f, 0.f, 0.f, 0.f}; acca[d] = (f32x4){0.f, 0.f, 0.f, 0.f};
#pragma unroll
                    for (int ksl = 0; ksl < 2; ++ksl) {
                        const bf16x8 wf = *(const LAS bf16x8*)(lds + 51200 + (d * 64 + nb * 16 + fr) * 144 + (32 * ksl + 8 * g) * 2);
                        const bf16x8 af = *(const LAS bf16x8*)(lds + 51200 + 18432 + (d * 64 + nb * 16 + fr) * 144 + (32 * ksl + 8 * g) * 2);
                        accw[d] = MFMA16(wf, xf[2 * d + ksl], accw[d]);
                        acca[d] = MFMA16(af, xf[4 + 2 * d + ksl], acca[d]); } }
#pragma unroll
                for (int ksl = 0; ksl < 4; ++ksl) { const bf16x8 gf = *(const LAS bf16x8*)(lds + 51200 + 36864 + (nb * 16 + fr) * 272 + (32 * ksl + 8 * g) * 2); accg = MFMA16(gf, xf[8 + ksl], accg); }
                const int c = h * 64 + nb * 16 + 4 * g;
                const f32x4 rc = bf4(*(const LAS u32x2*)(rkv + nb * 32)), vc = bf4(*(const LAS u32x2*)(rkv + 256 + nb * 32));
                const f32x4 w00 = *(const f32x4*)(w0 + c), w01 = *(const f32x4*)(w0 + BW + c), a00 = *(const f32x4*)(a0 + c), a01 = *(const f32x4*)(a0 + BW + c);
                const f32x4 kk4 = *(const f32x4*)(kkp + c), ka4 = *(const f32x4*)(kap + c), rk4 = *(const f32x4*)(rkp + c);
                float o[9][4];
#pragma unroll
                for (int e = 0; e < 4; ++e) {
                    const float ad0 = sigmoid_f(a00[e] + acca[0][e]), ad1 = sigmoid_f(a01[e] + acca[1][e]);
                    const float lw0 = -0.60653066f * sigmoid_f(w00[e] + accw[0][e]), lw1 = -0.60653066f * sigmoid_f(w01[e] + accw[1][e]);
                    const float k = kc[nb][e], kk = k * kk4[e] * inv;
                    const float kd0 = k * (1.f + (ad0 - 1.f) * ka4[e]), kd1 = k * (1.f + (ad1 - 1.f) * ka4[e]);
                    bon += rc[e] * (kd0 + kd1) * rk4[e];
                    o[0][e] = rc[e]; o[1][e] = vc[e]; o[2][e] = -kk; o[3][e] = lw0; o[4][e] = kd0; o[5][e] = kk * ad0; o[6][e] = lw1; o[7][e] = kd1; o[8][e] = kk * ad1;
                }
#pragma unroll
                for (int vv = 0; vv < 9; ++vv) { u32x2 w; w.x = pk2(o[vv][0], o[vv][1]); w.y = pk2(o[vv][2], o[vv][3]); *(u32x2*)(sp + vv * 64 + nb * 16) = w; }
                { u32x2 w; w.x = pk2(accg[0], accg[1]); w.y = pk2(accg[2], accg[3]); *(u32x2*)(G + (size_t)m * BW + c) = w; }
            }
            bon += __shfl_xor(bon, 16); bon += __shfl_xor(bon, 32);
#pragma unroll
            for (int nb = 0; nb < 4; ++nb) { const int c = h * 64 + nb * 16 + 4 * g;
                const f32x4 t = bf4(*(const LAS u32x2*)(rkv + 256 + nb * 32)) * bon;
                u32x2 w; w.x = pk2(t.x, t.y); w.y = pk2(t.z, t.w); *(u32x2*)(BV + (size_t)m * BW + c) = w; }
            asm volatile("" ::: "memory");
        }
    }
}

#ifndef SCAN_NCW
#define SCAN_NCW 4
#endif
constexpr int NCW = SCAN_NCW, RPB = 4 * NCW, BPH = 64 / RPB, SCAN_BLOCKS = 48 * BPH, TT = 32, NTILE = SL / TT;
struct StepOps { f32x4 r, a, w, k, b; float v; };
typedef float f32x2 __attribute__((ext_vector_type(2)));
template <int DIR> __device__ __forceinline__ void scan_tile(const LAS float* opq, const LAS float* opv, LAS float* ybq, f32x2& Sx, f32x2& Sy) {
#define TR(i) (DIR ? (TT - 1 - (i)) : (i))
#define SCAN_LOAD(o, i) do { const LAS float* bp = opq + TR(i) * 384; \
        o.r = *(const LAS f32x4*)(bp); o.a = *(const LAS f32x4*)(bp + 128); o.w = *(const LAS f32x4*)(bp + 192); o.k = *(const LAS f32x4*)(bp + 256); o.b = *(const LAS f32x4*)(bp + 320); \
        o.v = opv[TR(i) * 384]; asm volatile("" ::: "memory"); } while (0)
#define SCAN_STEP(o, i) do { \
        f32x2 t_ = Sx * o.a.lo; t_ = Sy * o.a.hi + t_; float sa = t_.x + t_.y; sa = allreduce16(sa); \
        const f32x2 kx_ = o.k.lo * o.v, ky_ = o.k.hi * o.v; \
        Sx = Sx * o.w.lo + (o.b.lo * sa + kx_); Sy = Sy * o.w.hi + (o.b.hi * sa + ky_); \
        f32x2 u_ = Sx * o.r.lo; u_ = Sy * o.r.hi + u_; float yv_ = u_.x + u_.y; yv_ += dpp_mov<0x128>(yv_); ybq[TR(i) * RPB * 8] = yv_; asm volatile("" ::: "memory"); } while (0)
    StepOps X0, X1, X2, X3;
    SCAN_LOAD(X0, 0); SCAN_LOAD(X1, 1);
#pragma unroll
    for (int i = 0; i < TT; i += 4) {
        SCAN_LOAD(X2, i + 2); SCAN_STEP(X0, i);
        SCAN_LOAD(X3, i + 3); SCAN_STEP(X1, i + 1);
        if (i + 4 < TT) SCAN_LOAD(X0, i + 4);
        SCAN_STEP(X2, i + 2);
        if (i + 4 < TT) SCAN_LOAD(X1, i + 5);
        SCAN_STEP(X3, i + 3);
    }
#undef TR
#undef SCAN_LOAD
#undef SCAN_STEP
}
__device__ __forceinline__ void scan_block(int pair, int part, const bf16* SOP, bf16* Y, LAS unsigned char* lds, int tid, int wave, int lane, int pf = 3) {
    static_assert(NCW == 4, "waves 0-3 compute, waves 4-7 stage operands and write y out");
    const int d = pair / 24, b = (pair % 24) / 12, h = pair % 12;
    LAS float* op0 = (LAS float*)lds;
    LAS float* op1 = (LAS float*)(lds + 49152);
    LAS float* yb0 = (LAS float*)(lds + 98304);
    LAS float* yb1 = (LAS float*)(lds + 98304 + 32 * RPB * 8 * 4);
    const int q = lane & 15, rl = (wave & 3) * 4 + (lane >> 4);
    const bf16* sbase = SOP + (size_t)((b * NH + h) * SL) * 576;
    const int ht = tid - 256, part8 = ht & 7, stok = ht >> 3;
    u32x4 sa_[6], sb_[6];
#define SCAN_S0(j) (d == 0 ? TT * (j) : ((j) < 8 ? CTXL - TT * ((j) + 1) : SL - TT * ((j) - 8 + 1)))
#define SCAN_ISSUE(dst, j) do { const bf16* sp_ = sbase + ((size_t)SCAN_S0(j) + stok) * 576 + part8 * 8; \
        _Pragma("unroll") for (int i = 0; i < 6; ++i) dst[i] = *(const u32x4*)(sp_ + ((i < 3) ? i : 3 + 3 * d + (i - 3)) * 64); } while (0)
#define SCAN_STAGE(src, opb) do { _Pragma("unroll") for (int i = 0; i < 6; ++i) { \
            f32x4 lo = {bflo(src[i].x), bfhi(src[i].x), bflo(src[i].y), bfhi(src[i].y)}, hi = {bflo(src[i].z), bfhi(src[i].z), bflo(src[i].w), bfhi(src[i].w)}; \
            if (i == 3) { lo.x = __expf(lo.x); lo.y = __expf(lo.y); lo.z = __expf(lo.z); lo.w = __expf(lo.w); hi.x = __expf(hi.x); hi.y = __expf(hi.y); hi.z = __expf(hi.z); hi.w = __expf(hi.w); } \
            LAS float* dp = opb + (stok * 6 + i) * 64 + part8 * 8; *(LAS f32x4*)dp = lo; *(LAS f32x4*)(dp + 4) = hi; } } while (0)
#define SCAN_BAR() do { asm volatile("s_waitcnt lgkmcnt(0)" ::: "memory"); __builtin_amdgcn_s_barrier(); asm volatile("" ::: "memory"); } while (0)
#define SCAN_YOUT(ybuf, j) do { const int s0_ = SCAN_S0(j); _Pragma("unroll") for (int i = 0; i < RPB / 8; ++i) { const int idx = ht + 256 * i, tok = idx / RPB, r = idx % RPB; const LAS f32x4* yp = (const LAS f32x4*)(ybuf + idx * 8); \
            const f32x4 t = yp[0] + yp[1]; \
            Y[((size_t)((d * 2 + b) * SL + s0_ + tok)) * BW + h * 64 + part * RPB + r] = (bf16)f2bf((t.x + t.y) + (t.z + t.w)); } } while (0)
#define SCAN_TILE(nxt, j, opc, opn, ybc, ybp) do { \
        if (wave < 4) { if (!(pf & 4)) { \
            if (d == 0) scan_tile<0>(opc + 4 * q, opc + 64 + part * RPB + rl, ybc + rl * 8 + (q & 7), Sx, Sy); \
            else        scan_tile<1>(opc + 4 * q, opc + 64 + part * RPB + rl, ybc + rl * 8 + (q & 7), Sx, Sy); } \
        } else { \
            if ((j) + 1 < NTILE) SCAN_STAGE(nxt, opn); \
            if ((j) + 3 < NTILE) SCAN_ISSUE(nxt, (j) + 3); \
            if ((j) > 0) SCAN_YOUT(ybp, (j) - 1); } \
        SCAN_BAR(); } while (0)
    f32x2 Sx = {0.f, 0.f}, Sy = {0.f, 0.f};
    if (wave < 4) __builtin_amdgcn_s_setprio(3);
    if (wave >= 4) { SCAN_ISSUE(sa_, 0); SCAN_ISSUE(sb_, 1); SCAN_STAGE(sa_, op0); SCAN_ISSUE(sa_, 2); }
    SCAN_BAR();
#pragma unroll 1
    for (int j = 0; j < NTILE; j += 2) { SCAN_TILE(sb_, j, op0, op1, yb0, yb1); SCAN_TILE(sa_, j + 1, op1, op0, yb1, yb0); }
    __builtin_amdgcn_s_setprio(0);
    if (wave >= 4) SCAN_YOUT(yb1, NTILE - 1);
    __syncthreads();
#undef SCAN_TILE
#undef SCAN_YOUT
#undef SCAN_BAR
#undef SCAN_STAGE
#undef SCAN_S0
#undef SCAN_ISSUE
}

constexpr int KSTR = 72;
__device__ __forceinline__ void na_item(int item, const bf16* Z, const float* rpb, bf16* CC, LAS unsigned char* lds, int tid, int wave, int lane) {
    LAS bf16* Ks = (LAS bf16*)lds;
    LAS bf16* Vt = (LAS bf16*)(lds + 9216);
    LAS float* rp = (LAS float*)(lds + 18432);
    const int fr = lane & 15, g = lane >> 4;
    int b, h, is_ctx, qrow, ustart = 0, nloc = 0; size_t mq;
    if (item < 1536) { is_ctx = 0; b = item / 768; const int r = item % 768; h = r / 64; const int rpi = r % 64; const int ri0 = 2 * rpi;
        qrow = ri0 + (wave >> 2); ustart = min(max(ri0 - 4, 0), 120); nloc = min(max(ri0 + 1 - 4, 0), 120) + 8 - ustart;
        mq = (size_t)b * SEQ + qrow * 64 + (wave & 3) * 16 + fr; }
    else { is_ctx = 1; const int r = item - 1536; b = r / 24; h = (r % 24) >> 1; const int p = r & 1; qrow = 0;
        mq = (size_t)ML + b * CTXL + (2 * p + (wave >> 2)) * 64 + (wave & 3) * 16 + fr; }
    const int ci = (wave & 3) * 16 + fr;
    const int wstart = min(max(qrow - 4, 0), 120);
    const int cs = min(max(ci - 8, 0), 48);
    __syncthreads();
    if (!is_ctx) for (int i = tid; i < 465; i += NTHR) rp[i] = rpb[h * 465 + i];
    bf16x8 qf[2];
#pragma unroll
    for (int ks = 0; ks < 2; ++ks) qf[ks] = *(const bf16x8*)(Z + mq * INCP + ZC0 + h * 64 + 32 * ks + 8 * g);
    const int key = tid >> 3, ch = tid & 7;
    auto krow = [&](int t) -> size_t { return t < 9 ? (size_t)b * SEQ + (ustart + t) * 64 + key : (size_t)ML + b * CTXL + (t - 9) * 64 + key; };
    const int ntl = nloc + 4;
#define NA_TID(p) ((p) < nloc ? (p) : 9 + (p) - nloc)
#define NA_LOAD(kd, vd, p) do { const bf16* zp_ = Z + krow(NA_TID(p)) * INCP + ZC0 + h * 64 + ch * 8; kd = *(const u32x4*)(zp_ + 768); vd = *(const u32x4*)(zp_ + 1536); } while (0)
    u32x4 k0 = {0u, 0u, 0u, 0u}, v0 = k0, k1 = k0, v1 = k0, k2 = k0, v2 = k0;
    NA_LOAD(k0, v0, 0); NA_LOAD(k1, v1, 1); NA_LOAD(k2, v2, 2);
    int doff[4][4]; float madd[4][4];
#pragma unroll
    for (int nb = 0; nb < 4; ++nb)
#pragma unroll
        for (int e = 0; e < 4; ++e) { const int ck = nb * 16 + 4 * g + e; doff[nb][e] = min(max(ck - ci + 15, 0), 30); madd[nb][e] = ((ck >= cs) && (ck < cs + 16)) ? 0.f : -1e30f; }
    const int qblk = wave & 3, nlo = (qblk >= 2) ? qblk - 1 : 0, nhi = (qblk <= 1) ? qblk + 1 : 3;
    float mrun = -1e30f, lrun = 0.f;
    f32x4 oacc[4];
#pragma unroll
    for (int nb = 0; nb < 4; ++nb) oacc[nb] = (f32x4){0.f, 0.f, 0.f, 0.f};
    for (int p = 0; p < ntl; ++p) {
        const int t = NA_TID(p);
        __syncthreads();
        *(LAS u32x4*)(Ks + key * KSTR + ch * 8) = k0;
        { const unsigned w[4] = {v0.x, v0.y, v0.z, v0.w};
#pragma unroll
          for (int e = 0; e < 4; ++e) { Vt[(ch * 8 + 2 * e) * KSTR + key] = (bf16)(w[e] & 0xffffu); Vt[(ch * 8 + 2 * e + 1) * KSTR + key] = (bf16)(w[e] >> 16); } }
        __syncthreads();
        k0 = k1; v0 = v1; k1 = k2; v1 = v2;
        if (p + 3 < ntl) NA_LOAD(k2, v2, p + 3);
        const int br = ustart + t;
        const bool active = (t >= 9) || (br >= wstart && br < wstart + 8);
        if (active) {
            const bool loc = t < 9;
            f32x4 sc[4];
            float mt = -1e30f;
            const int dr31 = (br - qrow + 7) * 31;
#pragma unroll
            for (int nb = 0; nb < 4; ++nb) {
                const bool nbon = !loc || (nb >= nlo && nb <= nhi);
                sc[nb] = (f32x4){0.f, 0.f, 0.f, 0.f};
                if (nbon) {
#pragma unroll
                    for (int ks = 0; ks < 2; ++ks) { const bf16x8 kf = *(const LAS bf16x8*)(Ks + (nb * 16 + fr) * KSTR + 32 * ks + 8 * g); sc[nb] = MFMA16(kf, qf[ks], sc[nb]); }
                    if (loc) {
#pragma unroll
                        for (int e = 0; e < 4; ++e) { const float v = (sc[nb][e] * 0.125f + rp[dr31 + doff[nb][e]]) + madd[nb][e]; sc[nb][e] = v; mt = fmaxf(mt, v); }
                    } else {
#pragma unroll
                        for (int e = 0; e < 4; ++e) { const float v = sc[nb][e] * 0.125f; sc[nb][e] = v; mt = fmaxf(mt, v); }
                    }
                }
            }
            mt = fmaxf(mt, __shfl_xor(mt, 16)); mt = fmaxf(mt, __shfl_xor(mt, 32));
            const float mnew = fmaxf(mrun, mt), alpha = __expf(mrun - mnew); mrun = mnew;
            float ps = 0.f;
#pragma unroll
            for (int nb = 0; nb < 4; ++nb) {
                const bool nbon = !loc || (nb >= nlo && nb <= nhi);
                if (nbon) {
#pragma unroll
                    for (int e = 0; e < 4; ++e) { const float pp = __expf(sc[nb][e] - mnew); sc[nb][e] = pp; ps += pp; }
                } else sc[nb] = (f32x4){0.f, 0.f, 0.f, 0.f};
            }
            lrun = lrun * alpha + ps;
            bf16x8 pf[2];
#pragma unroll
            for (int ks = 0; ks < 2; ++ks) { u32x4 w; w.x = pk2(sc[2 * ks][0], sc[2 * ks][1]); w.y = pk2(sc[2 * ks][2], sc[2 * ks][3]); w.z = pk2(sc[2 * ks + 1][0], sc[2 * ks + 1][1]); w.w = pk2(sc[2 * ks + 1][2], sc[2 * ks + 1][3]);
                pf[ks] = __builtin_bit_cast(bf16x8, w); }
#pragma unroll
            for (int nb = 0; nb < 4; ++nb) oacc[nb] = oacc[nb] * alpha;
#pragma unroll
            for (int ks = 0; ks < 2; ++ks) {
                const bool kson = !loc || (2 * ks + 1 >= nlo && 2 * ks <= nhi);
                if (kson) {
#pragma unroll
                    for (int nb = 0; nb < 4; ++nb) { const LAS bf16* vp = Vt + (nb * 16 + fr) * KSTR + 32 * ks + 4 * g;
                        const u32x2 lo = *(const LAS u32x2*)vp, hi = *(const LAS u32x2*)(vp + 16);
                        u32x4 w; w.x = lo.x; w.y = lo.y; w.z = hi.x; w.w = hi.y;
                        oacc[nb] = MFMA16(__builtin_bit_cast(bf16x8, w), pf[ks], oacc[nb]); }
                }
            }
        }
    }
#undef NA_TID
#undef NA_LOAD
    lrun += __shfl_xor(lrun, 16); lrun += __shfl_xor(lrun, 32);
    const float il = 1.f / lrun;
    bf16* op = CC + mq * D + 1280 + h * 64 + 4 * g;
#pragma unroll
    for (int nb = 0; nb < 4; ++nb) { u32x2 w; w.x = pk2(oacc[nb][0] * il, oacc[nb][1] * il); w.y = pk2(oacc[nb][2] * il, oacc[nb][3] * il); *(u32x2*)(op + nb * 16) = w; }
}

constexpr int VSTR = 136;
__device__ __forceinline__ void gmlp_item(int item, const bf16* Z, const bf16* gmws, const float* gmbs, bf16* CC, LAS unsigned char* lds, int tid, int wave, int lane) {
    LAS bf16* vt = (LAS bf16*)lds;
    const int cidx = item >> 3, gi = item & 7, fr = lane & 15, g = lane >> 4;
    __syncthreads();
    { const int j = tid >> 2, part = tid & 3; const bf16* zp = Z + (size_t)(cidx * 128 + j) * INCP + 512 + gi * 64 + 16 * part;
      const u32x4 a = *(const u32x4*)zp, bq = *(const u32x4*)(zp + 8);
      float x[16]; const unsigned w[8] = {a.x, a.y, a.z, a.w, bq.x, bq.y, bq.z, bq.w};
      float s = 0.f;
#pragma unroll
      for (int e = 0; e < 8; ++e) { x[2 * e] = gelu_f(bflo(w[e])); x[2 * e + 1] = gelu_f(bfhi(w[e])); s += x[2 * e] + x[2 * e + 1]; }
      s += __shfl_xor(s, 1); s += __shfl_xor(s, 2); const float mu = s * (1.f / 64.f); float s2 = 0.f;
#pragma unroll
      for (int e = 0; e < 16; ++e) { x[e] -= mu; s2 += x[e] * x[e]; }
      s2 += __shfl_xor(s2, 1); s2 += __shfl_xor(s2, 2); const float rstd = rsqrtf(s2 * (1.f / 64.f) + LN_EPS);
#pragma unroll
      for (int e = 0; e < 16; ++e) vt[(16 * part + e) * VSTR + j] = (bf16)f2bf(x[e] * rstd); }
    __syncthreads();
    f32x4 acc[4];
#pragma unroll
    for (int nb = 0; nb < 4; ++nb) acc[nb] = (f32x4){0.f, 0.f, 0.f, 0.f};
    const int i = wave * 16 + fr;
#pragma unroll
    for (int ks = 0; ks < 4; ++ks) { const bf16x8 wf = *(const bf16x8*)(gmws + (size_t)(gi * 128 + i) * 128 + 32 * ks + 8 * g);
#pragma unroll
        for (int nb = 0; nb < 4; ++nb) { const bf16x8 vf = *(const LAS bf16x8*)(vt + (nb * 16 + fr) * VSTR + 32 * ks + 8 * g); acc[nb] = MFMA16(vf, wf, acc[nb]); } }
    const float bs = gmbs[gi * 128 + i];
    const size_t m = (size_t)cidx * 128 + i;
#pragma unroll
    for (int nb = 0; nb < 4; ++nb) { const int c = nb * 16 + 4 * g; const f32x4 u = bf4(*(const u32x2*)(Z + m * INCP + gi * 64 + c));
        u32x2 w; w.x = pk2(gelu_f(u.x) * (acc[nb][0] + bs), gelu_f(u.y) * (acc[nb][1] + bs)); w.y = pk2(gelu_f(u.z) * (acc[nb][2] + bs), gelu_f(u.w) * (acc[nb][3] + bs));
        *(u32x2*)(CC + m * D + gi * 64 + c) = w; }
}

__device__ __forceinline__ void rwkv_out_phase(int nrows, const bf16* Y, const bf16* G, const bf16* BV, const float* gng, const float* gnb, bf16* CC, int tid) {
    const int l16 = tid & 15;
    for (int gi = (blockIdx.x * NTHR + tid) >> 4; gi < nrows * NH; gi += (gridDim.x * NTHR) >> 4) {
        const int m = gi / NH, h = gi % NH; int b, s;
        if (m < ML) { b = m >> 13; s = CTXL + (m & 8191); } else { b = (m - ML) >> 8; s = (m - ML) & 255; }
        const int c = h * 64 + 4 * l16;
        const f32x4 y0 = bf4(*(const u32x2*)(Y + ((size_t)(b * SL + s)) * BW + c)), y1 = bf4(*(const u32x2*)(Y + ((size_t)((2 + b) * SL + s)) * BW + c));
        f32x4 y = y0 + y1;
        float sm = (y.x + y.y) + (y.z + y.w);
#pragma unroll
        for (int o = 1; o < 16; o <<= 1) sm += __shfl_xor(sm, o);
        const float mu = sm * (1.f / 64.f); y = y - mu;
        float s2 = (y.x * y.x + y.y * y.y) + (y.z * y.z + y.w * y.w);
#pragma unroll
        for (int o = 1; o < 16; o <<= 1) s2 += __shfl_xor(s2, o);
        const float rstd = rsqrtf(s2 * (1.f / 64.f) + GN_EPS);
        const f32x4 gg = *(const f32x4*)(gng + c), gb = *(const f32x4*)(gnb + c);
        const f32x4 bv = bf4(*(const u32x2*)(BV + (size_t)m * BW + c)), gt = bf4(*(const u32x2*)(G + (size_t)m * BW + c));
        const f32x4 o = (y * rstd * gg + gb + bv) * gt;
        u32x2 w; w.x = pk2(o.x, o.y); w.y = pk2(o.z, o.w);
        *(u32x2*)(CC + (size_t)m * D + 512 + c) = w;
    }
}

#ifndef PER_PHASE_LAUNCH
#define PER_PHASE_LAUNCH 0
#endif
#ifndef PH_MASK
#define PH_MASK 0x7ff
#endif
#define PHON(k) ((PH_MASK >> (k)) & 1)
#ifndef NA_EARLY
#define NA_EARLY 580
#endif
#ifndef WGM_N2048
#define WGM_N2048 4
#endif
#ifndef WGM_N8192
#define WGM_N8192 4
#endif
constexpr int N_PHASES = 21;
struct Args { In in; float* out; unsigned char* ws; int ph_lo, ph_hi; };
#define XB_TMO      128
#define XB_XCNT(j)  (256  + 64 * (j))
#define XB_XSUB(j)  (1280 + 64 * (j))
#define XB_XGEN(j)  (2304 + 64 * (j))
#define XB_TOP      3328
#define XB_TOPGEN   3392
#define XCD_BAR_WORDS 3456
#define XB_SPIN_CAP (1u << 18)

__device__ __forceinline__ unsigned xb_ld(unsigned* p)              { return __hip_atomic_load(p, __ATOMIC_RELAXED, __HIP_MEMORY_SCOPE_AGENT); }
__device__ __forceinline__ unsigned xb_add(unsigned* p, unsigned v) { return __hip_atomic_fetch_add(p, v, __ATOMIC_RELAXED, __HIP_MEMORY_SCOPE_AGENT); }
__device__ __forceinline__ unsigned xb_xcc_id() { return (unsigned)__builtin_amdgcn_s_getreg((3 << 11) | 20) & 0xFu; }
#define XB_SPIN(cond, bar) do { unsigned _sp = 0; while (cond) { __builtin_amdgcn_s_sleep(1); \
    if ((++_sp & 255u) == 0u) { if (xb_ld(&(bar)[XB_TMO])) break; if (_sp > XB_SPIN_CAP) { atomicAdd(&(bar)[XB_TMO], 1u); break; } } } } while (0)

struct XcdBarrier {
    unsigned* bar; unsigned x;
    volatile LAS unsigned* st;
};

__device__ __forceinline__ XcdBarrier xcd_barrier_post(unsigned* bar, volatile LAS unsigned* st) {
    XcdBarrier b; b.bar = bar; b.x = xb_xcc_id(); b.st = st;
    if (threadIdx.x == 0) (void)xb_add(&bar[XB_XCNT(b.x)], 1u);
    return b;
}
__device__ __forceinline__ void xcd_barrier_complete(unsigned* bar, unsigned x, unsigned& nloc, unsigned& nx) {
    const unsigned G = gridDim.x * gridDim.y * gridDim.z;
    unsigned sum, cnt, mine, sp = 0u;
    for (;;) {
        sum = 0u; cnt = 0u; mine = 0u;
#pragma unroll
        for (unsigned j = 0; j < 16; ++j) { const unsigned c = xb_ld(&bar[XB_XCNT(j)]); sum += c; cnt += (c > 0u) ? 1u : 0u; mine = (j == x) ? c : mine; }
        if (sum == G) break;
        __builtin_amdgcn_s_sleep(1);
        if ((++sp & 255u) == 0u) { if (xb_ld(&bar[XB_TMO])) break; if (sp > XB_SPIN_CAP) { atomicAdd(&bar[XB_TMO], 1u); break; } }
    }
    nloc = mine > 0u ? mine : 1u; nx = cnt > 0u ? cnt : 1u;
}

__device__ __forceinline__ void xcd_barrier(const XcdBarrier& b) {
    asm volatile("s_waitcnt vmcnt(0)" ::: "memory");
    __syncthreads();
    if (threadIdx.x == 0) {
        unsigned* bar = b.bar;
        __builtin_amdgcn_s_waitcnt(0);
        unsigned nloc = b.st[0], nx = b.st[1];
        if (nloc == 0u) { xcd_barrier_complete(bar, b.x, nloc, nx); b.st[0] = nloc; b.st[1] = nx; }
        const unsigned old = xb_add(&bar[XB_XSUB(b.x)], 1u);
        const unsigned gen = old / nloc;
        if (old + 1u == (gen + 1u) * nloc) {
            __builtin_amdgcn_fence(__ATOMIC_RELEASE, "agent");
            asm volatile("s_waitcnt vmcnt(0)" ::: "memory");
            const unsigned og = xb_add(&bar[XB_TOP], 1u);
            const unsigned tg = og / nx;
            if (og + 1u == (tg + 1u) * nx) xb_add(&bar[XB_TOPGEN], 1u);
            else XB_SPIN(xb_ld(&bar[XB_TOPGEN]) == tg, bar);
            __builtin_amdgcn_fence(__ATOMIC_ACQUIRE, "agent");
            xb_add(&bar[XB_XGEN(b.x)], 1u);
            asm volatile("s_waitcnt vmcnt(0)" ::: "memory");
        } else {
            XB_SPIN(xb_ld(&bar[XB_XGEN(b.x)]) == gen, bar);
            __builtin_amdgcn_fence(__ATOMIC_ACQUIRE, "agent");
            asm volatile("s_waitcnt vmcnt(0)" ::: "memory");
        }
    }
    __syncthreads();
}

constexpr size_t WS_BAR = WS_CTL + 512 * 1024;
constexpr int LDS_BARW = LDS_BYTES - 64;

template <int PH> __device__ __forceinline__ void run_phase(const Args& args, LAS unsigned char* lds, int part = 3) {
    const int tid = threadIdx.x, lane = tid & 63, wave = __builtin_amdgcn_readfirstlane(tid >> 6);
    const int gw = blockIdx.x * NWAVES + wave, NGW = gridDim.x * NWAVES;
    const In& in = args.in;
    unsigned char* ws = args.ws;
    float* mod = (float*)(ws + WS_CTL);
    bf16* small = (bf16*)(ws + WS_SMALL);
    float* XC = (float*)(ws + WS_XC); float* XL = args.out;
    bf16* AC = (bf16*)(ws + WS_AC); bf16* Z = (bf16*)(ws + WS_Z);
    if constexpr (PH == 0) {
        if (PHON(10)) { mod_gemv(in, mod, gw, NGW, lane); convert_weights(in, 0, 0, ws, lds, gw, NGW, wave, lane); }
    } else {
        constexpr int l = (PH - 1) / 10, sub = (PH - 1) % 10;
        const float* modl = mod + (size_t)l * 3 * NMOD;
        constexpr int Mrows = (l == 0) ? MT : ML;
        if constexpr (sub == 0) {
            if (l == 0 && PHON(0)) rowwise(gw, NGW, lane, MT, in.p[0], in.p[2], XL, XC, false, in.p[22], in.p[23], true, modl, 0, 1, AC);
        } else if constexpr (sub == 1) { if (PHON(1)) {
            pg8::Gemm g{AC, (bf16*)(ws + WS_WIN), ML, INCP, D}; pg8::StaticOrder S; S.init(ML, INCP, (int)gridDim.x, (int)blockIdx.x);
            EpiStoreBf16<0> E{Z, INCP};
            pg8::gemm_phase<EpiStoreBf16<0>, pg8::StaticOrder, true, true>(lds, g, S, E); }
        } else if constexpr (sub == 2) { if (PHON(2)) {
            rwkv_proj_phase(Z, in.p[9] + (size_t)l * 3 * BCOLS, in.p[10] + (size_t)l * 2 * BW, in.p[12] + (size_t)l * 2 * BW, in.p[15] + (size_t)l * BW, in.p[16] + (size_t)l * BW,
                            in.p[17] + (size_t)l * BW, small + SM_W2T, small + SM_A2T, small + SM_G2T, (bf16*)(ws + WS_SOP), (bf16*)(ws + WS_G), (bf16*)(ws + WS_BV), lds, tid, wave, lane);
            if ((int)blockIdx.x >= 140) for (int it = (int)blockIdx.x - 140; it < NA_EARLY; it += (int)gridDim.x - 140) na_item(it, Z, in.p[20] + (size_t)l * NH * 465, AC, lds, tid, wave, lane); }
        } else if constexpr (sub == 3) { if (PHON(3)) {
            if ((int)blockIdx.x < SCAN_BLOCKS) { if (part & 1) {
                const int blk = blockIdx.x, x = blk & 7, slot = blk >> 3, pair = x + 8 * (slot / BPH), quarter = slot % BPH;
                scan_block(pair, quarter, (const bf16*)(ws + WS_SOP), (bf16*)(ws + WS_Y), lds, tid, wave, lane, part); }
            } else if (part & 2) {
                constexpr int nNA = (l == 0) ? 1584 : 1536, nG = (l == 0) ? 1056 : 1024;
                for (int it = NA_EARLY + (int)blockIdx.x - SCAN_BLOCKS; it < nNA + nG; it += (int)gridDim.x - SCAN_BLOCKS) {
                    if (it < nNA) na_item(it, Z, in.p[20] + (size_t)l * NH * 465, AC, lds, tid, wave, lane);
                    else gmlp_item(it - nNA, Z, small + SM_GMWS, in.p[8] + (size_t)l * 1024, AC, lds, tid, wave, lane);
                }
                __syncthreads();
                convert_weights(in, l, 1, ws, lds, ((int)blockIdx.x - SCAN_BLOCKS) * NWAVES + wave, ((int)gridDim.x - SCAN_BLOCKS) * NWAVES, wave, lane);
            } }
        } else if constexpr (sub == 4) { if (PHON(4)) {
            rwkv_out_phase(Mrows, (const bf16*)(ws + WS_Y), (const bf16*)(ws + WS_G), (const bf16*)(ws + WS_BV), in.p[18] + (size_t)l * BW, in.p[19] + (size_t)l * BW, AC, tid); }
        } else if constexpr (sub == 5) { if (PHON(5)) {
            pg8::Gemm g{AC, (bf16*)(ws + WS_WOUT), ML, D, D}; pg8::StaticOrder S; S.init(ML, D, (int)gridDim.x, (int)blockIdx.x, WGM_N2048);
            EpiRes E{(l == 0) ? in.p[0] : (const float*)XL, (l == 0) ? in.p[2] : (const float*)XC, XL, XC, modl + 2 * D};
            pg8::gemm_phase<EpiRes, pg8::StaticOrder, true, true>(lds, g, S, E); }
        } else if constexpr (sub == 6) { if (PHON(6)) {
            rowwise(gw, NGW, lane, Mrows, XL, (l == 0) ? in.p[2] : (const float*)XC, XL, XC, true, in.p[22] + (size_t)l * D, in.p[23] + (size_t)l * D, true, modl, 3, 4, AC, (const float*)(ws + WS_SLAB), (l == 0) ? 8 : 0); }
        } else if constexpr (sub == 7) { if (PHON(7)) {
            pg8::Gemm g{AC, (bf16*)(ws + WS_WUP), Mrows, DFF, D}; pg8::StaticOrder S; S.init(Mrows, DFF, (int)gridDim.x, (int)blockIdx.x, WGM_N8192);
            EpiStoreBf16<1> E{(bf16*)(ws + WS_HM), DFF};
            pg8::gemm_phase<EpiStoreBf16<1>, pg8::StaticOrder, true, true>(lds, g, S, E); }
        } else if constexpr (sub == 8) { if (PHON(8)) {
            pg8::Gemm g{(bf16*)(ws + WS_HM), (bf16*)(ws + WS_WDN), ML, D, DFF}; pg8::StaticOrder S; S.init(ML, D, (int)gridDim.x, (int)blockIdx.x, WGM_N2048);
            EpiRes E{XL, XC, XL, XC, modl + 5 * D};
            pg8::gemm_phase<EpiRes, pg8::StaticOrder, true, true>(lds, g, S, E); }
        } else { if (PHON(9)) {
            rowwise(gw, NGW, lane, Mrows, XL, XC, XL, XC, true, in.p[26] + (size_t)l * D, in.p[27] + (size_t)l * D, l == 0, modl + 3 * NMOD, 0, 1, AC, (const float*)(ws + WS_SLAB), (l == 0) ? 16 : 0);
            if (l == 0) { __syncthreads(); convert_weights(in, 1, 0, ws, lds, gw, NGW, wave, lane); } }
        }
    }
}
template <int PH> __device__ __forceinline__ void run_ctx(const Args& args, LAS unsigned char* lds) {
    unsigned char* ws = args.ws;
    if constexpr (PH == 6 || PH == 9) {
        const float* modl = (const float*)(ws + WS_CTL);
        const int KS = (PH == 6) ? 256 : 512, LDK = (PH == 6) ? D : DFF, NS = (PH == 6) ? 8 : 16;
        const bf16* A = (PH == 6) ? (const bf16*)(ws + WS_AC) + (size_t)ML * D : (const bf16*)(ws + WS_HM) + (size_t)ML * DFF;
        const bf16* W = (PH == 6) ? (const bf16*)(ws + WS_WOUT) : (const bf16*)(ws + WS_WDN);
        pg8::Gemm g2{A, W, 2 * CTXL, D, KS, LDK}; SplitKOrder S2{2, 8, NS, (int)gridDim.x, (int)blockIdx.x};
        EpiSlabCtx E2{(float*)(ws + WS_SLAB), modl + 2 * NMOD + ((PH == 6) ? 2 : 5) * D, D};
        pg8::gemm_phase<EpiSlabCtx, SplitKOrder, true, true>(lds, g2, S2, E2);
    } else if constexpr (PH == 2 || PH == 12) {
        pg8::Gemm g2{(const bf16*)(ws + WS_AC) + (size_t)ML * D, (const bf16*)(ws + WS_WIN), 2 * CTXL, INCP, 512, D}; SplitKOrder S2{2, 24, 4, (int)gridDim.x, (int)blockIdx.x};
        EpiSlabCtx E2{(float*)(ws + WS_SLAB), nullptr, INCP};
        pg8::gemm_phase<EpiSlabCtx, SplitKOrder, true, true>(lds, g2, S2, E2);
    }
}
__device__ __forceinline__ void hctx_sum(const Args& args) {
    const float* slab = (const float*)(args.ws + WS_SLAB); bf16* H = (bf16*)(args.ws + WS_HM) + (size_t)ML * DFF;
    constexpr int NG = 2 * CTXL * DFF / 4; constexpr size_t SS = (size_t)2 * CTXL * DFF;
    for (int i = blockIdx.x * NTHR + threadIdx.x; i < NG; i += gridDim.x * NTHR) {
        f32x4 v = (*(const f32x4*)(slab + 4 * (size_t)i) + *(const f32x4*)(slab + SS + 4 * (size_t)i)) + (*(const f32x4*)(slab + 2 * SS + 4 * (size_t)i) + *(const f32x4*)(slab + 3 * SS + 4 * (size_t)i));
        v.x = fmaxf(v.x, 0.f); v.y = fmaxf(v.y, 0.f); v.z = fmaxf(v.z, 0.f); v.w = fmaxf(v.w, 0.f); v = v * v;
        u32x2 o; o.x = pk2(v.x, v.y); o.y = pk2(v.z, v.w); *(u32x2*)(H + 4 * (size_t)i) = o; }
}
__device__ __forceinline__ void zctx_sum(const Args& args) {
    const float* slab = (const float*)(args.ws + WS_SLAB); bf16* Z = (bf16*)(args.ws + WS_Z) + (size_t)ML * INCP;
    constexpr int NG = 2 * CTXL * INCP / 4; constexpr size_t SS = (size_t)2 * CTXL * INCP;
    for (int i = blockIdx.x * NTHR + threadIdx.x; i < NG; i += gridDim.x * NTHR) {
        const f32x4 v = (*(const f32x4*)(slab + 4 * (size_t)i) + *(const f32x4*)(slab + SS + 4 * (size_t)i)) + (*(const f32x4*)(slab + 2 * SS + 4 * (size_t)i) + *(const f32x4*)(slab + 3 * SS + 4 * (size_t)i));
        u32x2 o; o.x = pk2(v.x, v.y); o.y = pk2(v.z, v.w); *(u32x2*)(Z + 4 * (size_t)i) = o; }
}
__global__ void __launch_bounds__(NTHR, 2) fwd_megakernel(Args args) {
    extern __shared__ __attribute__((aligned(16))) unsigned char lds_raw[];
    LAS unsigned char* lds = (LAS unsigned char*)lds_raw;
    cg::grid_group grid = cg::this_grid();
    const int lo = args.ph_lo, hi = args.ph_hi;
    if (threadIdx.x < 16) ((LAS unsigned*)(lds + LDS_BARW))[threadIdx.x] = 0u;
    __syncthreads();
    const XcdBarrier xbar = xcd_barrier_post((unsigned*)(args.ws + WS_BAR), (volatile LAS unsigned*)(lds + LDS_BARW));
#define GRID_SYNC(PH) do { if ((PH) == 0) grid.sync(); else xcd_barrier(xbar); } while (0)
#ifndef REP_PART
#define REP_PART 3
#endif
#ifndef REP_MASK
#define REP_MASK 0
#endif
#define REPON(PH) ((PH) > 0 && ((REP_MASK >> (((PH) - 1) % 10)) & 1))
#define DO(PH) if (lo <= (PH) && (PH) < hi) { if (REPON(PH)) { if (REP_PART != 64) run_phase<PH>(args, lds, REP_PART); if ((PH) == 0) grid.sync(); else xcd_barrier(xbar); } run_phase<PH>(args, lds); run_ctx<PH>(args, lds); if ((PH) == 2 || (PH) == 12) { xcd_barrier(xbar); zctx_sum(args); } if ((PH) + 1 < hi) GRID_SYNC(PH); }
    DO(0) DO(1) DO(2) DO(3) DO(4) DO(5) DO(6) DO(7) DO(8) DO(9) DO(10)
    DO(11) DO(12) DO(13) DO(14) DO(15) DO(16) DO(17) DO(18) DO(19) DO(20)
#undef DO
}

extern "C" void kernel_launch(void* const* d_in, const int* in_sizes, int n_in, void* d_out, int out_size, void* d_ws, size_t ws_size, hipStream_t stream) {
    static int grid = 0;
    if (grid == 0) {
        if (n_in != 28 || ws_size < WS_END) { fprintf(stderr, "kernel_launch: unexpected n_in %d / ws_size %zu (need %zu)\n", n_in, ws_size, (size_t)WS_END); grid = -1; return; }
        int dev = 0, cus = 0;
        if (hipGetDevice(&dev) != hipSuccess || hipDeviceGetAttribute(&cus, hipDeviceAttributeMultiprocessorCount, dev) != hipSuccess) { grid = -1; return; }
        if (hipFuncSetAttribute((const void*)fwd_megakernel, hipFuncAttributeMaxDynamicSharedMemorySize, LDS_BYTES) != hipSuccess) { fprintf(stderr, "kernel_launch: hipFuncSetAttribute failed\n"); grid = -1; return; }
        grid = cus;
    }
    if (grid < 0) return;
    (void)hipMemsetAsync((char*)d_ws + WS_CTL, 0, CTL_BYTES, stream);
    Args a{};
    for (int i = 0; i < 28; ++i) a.in.p[i] = (const float*)d_in[i];
    a.out = (float*)d_out; a.ws = (unsigned char*)d_ws;
#if PER_PHASE_LAUNCH
    for (int ph = 0; ph < N_PHASES; ++ph) { a.ph_lo = ph; a.ph_hi = ph + 1; hipLaunchKernelGGL(fwd_megakernel, dim3(grid), dim3(NTHR), LDS_BYTES, stream, a); }
#else
    a.ph_lo = 0; a.ph_hi = N_PHASES;
    void* kargs[] = {&a};
    hipError_t e = hipLaunchCooperativeKernel((const void*)fwd_megakernel, dim3(grid), dim3(NTHR), kargs, LDS_BYTES, stream);
    if (e != hipSuccess) fprintf(stderr, "cooperative launch failed: %s (grid %d)\n", hipGetErrorString(e), grid);
#endif
}
```

```cpp
#include <hip/hip_runtime.h>
#include <hip/hip_cooperative_groups.h>
#include <cstdio>
#include <cstdint>
namespace cg = cooperative_groups;
#define NA_EARLY 464
namespace pg8 {
#define PG8_LAS __attribute__((address_space(3)))
typedef unsigned short bf16_t;
typedef short bf16x8 __attribute__((ext_vector_type(8)));
typedef float f32x4 __attribute__((ext_vector_type(4)));
typedef unsigned u32x4 __attribute__((ext_vector_type(4)));
constexpr int BM = 256, BK = 64, HALF = 128, HTB = HALF * BK * 2  , STAGE_BYTES = 8 * HTB, NXCD = 8, WGM = 8;

__host__ __device__ __forceinline__ int lds_byte(int r, int c) { const int st = (r >> 4) * 2 + (c >> 5), rr = r & 15, cc = c & 31, ob = rr * 64 + cc * 2; return st * 1024 + (ob ^ (((ob >> 9) & 1) << 5)); }
__host__ __device__ __forceinline__ void stage_rc(int b, int& R, int& C) { const int st = b / 1024, sb = b % 1024, swz = sb ^ (((sb >> 9) & 1) << 5); R = (st >> 1) * 16 + swz / 64; C = (st & 1) * 32 + (swz % 64) / 2; }
__host__ __device__ __forceinline__ int perm32(int rho) { const int n = rho >> 4, i = rho & 15; return 8 * (i >> 2) + 4 * n + (i & 3); }

struct Unit { int pm, pn, ks; };
struct Gemm { const bf16_t* A; const bf16_t* Bt; int M, N, K; int ld = 0; };

struct StaticOrder {
    int nM, nN, nwg, G, c, wgm;
    __host__ __device__ void init(int M, int N, int G_, int c_, int wgm_ = WGM) { nM = M / BM; nN = N / BM; nwg = nM * nN; G = G_; c = c_; wgm = wgm_; }
    __host__ __device__ bool next(int i, Unit& u) const {
        const long L = (long)i * G + c; if (L >= nwg) return false;
        int wgid = (int)L; { const int q = nwg / NXCD, r = nwg % NXCD, xcd = wgid % NXCD, off = wgid / NXCD; wgid = (xcd < r ? xcd * (q + 1) : r * (q + 1) + (xcd - r) * q) + off; }
        const int nig = wgm * nN, gid = wgid / nig, fm = gid * wgm, gsz = (nM - fm) < wgm ? (nM - fm) : wgm;
        u.pm = fm + ((wgid % nig) % gsz); u.pn = (wgid % nig) / gsz; u.ks = 0; return true;
    }
    __device__ __forceinline__ void a_ready(const Unit&) const {}
    __device__ __forceinline__ void done(const Unit&) const {}
};

__device__ __forceinline__ unsigned cvt_pk_bf16(float lo, float hi) { unsigned r; asm volatile("v_cvt_pk_bf16_f32 %0, %1, %2" : "=v"(r) : "v"(lo), "v"(hi)); return r; }
typedef float f32x2 __attribute__((ext_vector_type(2)));
__device__ __forceinline__ f32x2 gelu_pk(f32x2 v) {
    const f32x2 av = __builtin_elementwise_abs(v), d = av * 0.2316418882f + 1.0f;
    f32x2 t; t.x = __builtin_amdgcn_rcpf(d.x); t.y = __builtin_amdgcn_rcpf(d.y);
    f32x2 q = t * 0.5307027145f + (-0.7265760135f); q = q * t + 0.7107068705f; q = q * t + (-0.142248368f); q = q * t + 0.127414796f; q = q * t;
    const f32x2 s = (v * v) * (-0.72134752044f);
    f32x2 e; e.x = __builtin_amdgcn_exp2f(s.x); e.y = __builtin_amdgcn_exp2f(s.y);
    const f32x2 m = v * (q * e), r = v - m;
    f32x2 o; o.x = v.x < 0.f ? m.x : r.x; o.y = v.y < 0.f ? m.y : r.y; return o;
}

template <int ACT  > struct EpiBf16 {
    static constexpr bool PERM = true, AFTER_DRAIN = false; static_assert(ACT == 0 || ACT == 1, "EpiBf16: ACT is 0 (none) or 1 (gelu_pk)");
    bf16_t* O; int ldc; const float* bias; int split_cols; size_t split_stride; float scale0;
    __device__ __forceinline__ void operator()(const f32x4 (&acc)[2][2][4][2], const Unit& u, int wr, int wc, int fr, int fq) const {
        const int row0 = u.pm * BM + wr * 64 + fr; int colt = u.pn * BM; bf16_t* base = O;
        float sc = 1.f; if (split_cols) { const int t = colt / split_cols; base += (size_t)t * split_stride; colt -= t * split_cols; if (t == 0) sc = scale0; }
        const int col0 = colt + wc * 32 + 8 * fq, bcol0 = u.pn * BM + wc * 32 + 8 * fq;
        f32x4 bv[2][2];
#pragma unroll
        for (int bj = 0; bj < 2; ++bj)
#pragma unroll
            for (int n = 0; n < 2; ++n) bv[bj][n] = bias ? *(const f32x4*)(bias + bcol0 + bj * HALF + 4 * n) : (f32x4){0.f, 0.f, 0.f, 0.f};
#pragma unroll
        for (int ai = 0; ai < 2; ++ai)
#pragma unroll
            for (int m = 0; m < 4; ++m) { bf16_t* rowp = base + (size_t)(row0 + ai * HALF + m * 16) * ldc + col0;
#pragma unroll
                for (int bj = 0; bj < 2; ++bj) { f32x4 v0 = acc[ai][bj][m][0] + bv[bj][0], v1 = acc[ai][bj][m][1] + bv[bj][1];
                    if (ACT == 1) { f32x2 a = gelu_pk((f32x2){v0[0], v0[1]}), b = gelu_pk((f32x2){v0[2], v0[3]}), c = gelu_pk((f32x2){v1[0], v1[1]}), d = gelu_pk((f32x2){v1[2], v1[3]});
                        v0 = (f32x4){a.x, a.y, b.x, b.y}; v1 = (f32x4){c.x, c.y, d.x, d.y}; }
                    v0 = v0 * sc; v1 = v1 * sc; u32x4 w; w.x = cvt_pk_bf16(v0[0], v0[1]); w.y = cvt_pk_bf16(v0[2], v0[3]); w.z = cvt_pk_bf16(v1[0], v1[1]); w.w = cvt_pk_bf16(v1[2], v1[3]);
                    *(u32x4*)(rowp + bj * HALF) = w; } }
    }
};

template <class Epi, class Sched, bool ALIGN_EPI = false, bool SP2 = false>
__device__ __forceinline__ void gemm_phase(PG8_LAS unsigned char* lds, const Gemm g, const Sched& S, const Epi& E) {
    const int tid = threadIdx.x, wid = __builtin_amdgcn_readfirstlane(tid >> 6), lane = tid & 63, wr = wid >> 2, wc = wid & 3, fr = lane & 15, fq = lane >> 4;
    const int K = g.K, nt = K / BK, LD = g.ld ? g.ld : g.K;
    unsigned voffA[2], voffB[2];
#pragma unroll
    for (int i = 0; i < 2; ++i) { int R, C; stage_rc(tid * 16 + i * 8192, R, C); const int Rb = Epi::PERM ? ((R & ~31) + perm32(R & 31)) : R;
        voffA[i] = (unsigned)(R * LD + C) * 2u; voffB[i] = (unsigned)(Rb * LD + C) * 2u; }
    const size_t kstep = (size_t)(BK * 2);
    const size_t hstep = (size_t)HALF * LD * 2;
    const size_t tstep = 2 * hstep;
    const unsigned ldsw = (unsigned)wid * 1024u;
    const int aoff = lds_byte(wr * 64 + fr, fq * 8), boff = lds_byte(wc * 32 + fr, fq * 8);
#define PG8_SA(b, h) (((b) * 2 + (h)) * HTB)
#define PG8_SB(b, h) ((4 + (b) * 2 + (h)) * HTB)
#define PG8_STAGE(bufoff, gbase, voff) do { _Pragma("unroll") for (int _i = 0; _i < 2; ++_i) \
        __builtin_amdgcn_global_load_lds((const unsigned*)((const char*)(gbase) + (voff)[_i]), (PG8_LAS unsigned*)(lds + (bufoff) + ldsw + _i * 8192), 16, 0, 0); } while (0)
#define PG8_LDA(dst, b, h) do { _Pragma("unroll") for (int m = 0; m < 4; ++m) _Pragma("unroll") for (int k = 0; k < 2; ++k) dst[m][k] = *(const PG8_LAS bf16x8*)(lds + PG8_SA(b, h) + aoff + m * 2048 + k * 1024); } while (0)
#define PG8_LDB(dst, b, h) do { _Pragma("unroll") for (int n = 0; n < 2; ++n) _Pragma("unroll") for (int k = 0; k < 2; ++k) dst[n][k] = *(const PG8_LAS bf16x8*)(lds + PG8_SB(b, h) + boff + n * 2048 + k * 1024); } while (0)
#define PG8_MMA(ai, bj, At, Bt) do { __builtin_amdgcn_s_setprio(1); _Pragma("unroll") for (int m = 0; m < 4; ++m) _Pragma("unroll") for (int n = 0; n < 2; ++n) _Pragma("unroll") for (int k = 0; k < 2; ++k) \
        acc[ai][bj][m][n] = __builtin_amdgcn_mfma_f32_16x16x32_bf16(Bt[n][k], At[m][k], acc[ai][bj][m][n], 0, 0, 0); __builtin_amdgcn_s_setprio(0); } while (0)
#define PG8_WAIT_V(n) asm volatile("s_waitcnt vmcnt(" #n ")" ::: "memory")
#define PG8_WAIT_L(n) asm volatile("s_waitcnt lgkmcnt(" #n ")" ::: "memory")
#define PG8_BAR __builtin_amdgcn_s_barrier()
#define PG8_SCHED __builtin_amdgcn_sched_barrier(0)
    Unit cur, nxt; int ui = 0;
    if (!S.next(0, cur)) return;
    f32x4 acc[2][2][4][2];
#pragma unroll
    for (int a = 0; a < 2; ++a)
#pragma unroll
        for (int b = 0; b < 2; ++b)
#pragma unroll
            for (int m = 0; m < 4; ++m)
#pragma unroll
                for (int n = 0; n < 2; ++n) acc[a][b][m][n] = (f32x4){0.f, 0.f, 0.f, 0.f};
    bf16x8 At[4][2], B0[2][2], B1[2][2];
    const char* cA = (const char*)g.A + (size_t)cur.pm * tstep + (size_t)cur.ks * K * 2; const char* cB = (const char*)g.Bt + (size_t)cur.pn * tstep + (size_t)cur.ks * K * 2;
    S.a_ready(cur);
    if constexpr (SP2) {
        PG8_STAGE(PG8_SB(0, 0), cB, voffB); PG8_STAGE(PG8_SB(0, 1), cB + hstep, voffB); PG8_STAGE(PG8_SA(0, 0), cA, voffA); PG8_STAGE(PG8_SA(0, 1), cA + hstep, voffA);
        if (wr == 1) PG8_BAR;
        PG8_WAIT_V(2); PG8_BAR;
        PG8_STAGE(PG8_SB(1, 0), cB + kstep, voffB); PG8_STAGE(PG8_SA(1, 0), cA + kstep, voffA); PG8_STAGE(PG8_SB(1, 1), cB + hstep + kstep, voffB);
        PG8_WAIT_V(6); PG8_BAR;
    } else {
        PG8_STAGE(PG8_SB(0, 0), cB, voffB); PG8_STAGE(PG8_SA(0, 0), cA, voffA); PG8_STAGE(PG8_SB(0, 1), cB + hstep, voffB); PG8_STAGE(PG8_SA(0, 1), cA + hstep, voffA);
        if (wr == 1) PG8_BAR;
        PG8_WAIT_V(4); PG8_BAR;
        PG8_STAGE(PG8_SB(1, 0), cB + kstep, voffB); PG8_STAGE(PG8_SA(1, 0), cA + kstep, voffA); PG8_STAGE(PG8_SB(1, 1), cB + hstep + kstep, voffB);
        PG8_WAIT_V(6); PG8_BAR;
    }
    for (;;) {
        const bool has_next = S.next(ui + 1, nxt);
        const char* nA = has_next ? (const char*)g.A + (size_t)nxt.pm * tstep + (size_t)nxt.ks * K * 2 : cA; const char* nB = has_next ? (const char*)g.Bt + (size_t)nxt.pn * tstep + (size_t)nxt.ks * K * 2 : cB;
        for (int t = 0; t < nt; t += 2) {
            const bool last = (t == nt - 2);
            const char* a1 = cA + (size_t)(t + 1) * kstep;
            const char* a2 = last ? nA : cA + (size_t)(t + 2) * kstep; const char* b2 = last ? nB : cB + (size_t)(t + 2) * kstep;
            const char* a3 = a2 + kstep; const char* b3 = b2 + kstep;
            if (last && has_next) S.a_ready(nxt);
            if constexpr (SP2) {
            PG8_LDB(B0, 0, 0); PG8_LDB(B1, 0, 1); PG8_SCHED; PG8_LDA(At, 0, 0); PG8_STAGE(PG8_SA(1, 1), a1 + hstep, voffA);
            PG8_WAIT_V(8); PG8_WAIT_L(0); PG8_BAR; PG8_MMA(0, 0, At, B0); PG8_MMA(0, 1, At, B1); PG8_BAR; PG8_SCHED;
            PG8_LDA(At, 0, 1); PG8_STAGE(PG8_SB(0, 0), b2, voffB); PG8_STAGE(PG8_SB(0, 1), b2 + hstep, voffB); PG8_STAGE(PG8_SA(0, 0), a2, voffA);
            PG8_WAIT_V(8); PG8_WAIT_L(0); PG8_BAR; PG8_MMA(1, 0, At, B0); PG8_MMA(1, 1, At, B1); PG8_BAR; PG8_SCHED;
            PG8_LDB(B0, 1, 0); PG8_LDB(B1, 1, 1); PG8_SCHED; PG8_LDA(At, 1, 0); PG8_STAGE(PG8_SA(0, 1), a2 + hstep, voffA);
            PG8_WAIT_V(8); PG8_WAIT_L(0); PG8_BAR; PG8_MMA(0, 0, At, B0); PG8_MMA(0, 1, At, B1); PG8_BAR; PG8_SCHED;
            PG8_LDA(At, 1, 1); PG8_STAGE(PG8_SB(1, 0), b3, voffB); PG8_STAGE(PG8_SB(1, 1), b3 + hstep, voffB); PG8_STAGE(PG8_SA(1, 0), a3, voffA);
            PG8_WAIT_V(8); PG8_WAIT_L(0); PG8_BAR; PG8_MMA(1, 0, At, B0); PG8_MMA(1, 1, At, B1); PG8_BAR; PG8_SCHED;
            } else {
            PG8_LDB(B0, 0, 0); PG8_SCHED; PG8_LDA(At, 0, 0); PG8_STAGE(PG8_SA(1, 1), a1 + hstep, voffA);
            PG8_WAIT_L(8); PG8_BAR; PG8_WAIT_L(0); PG8_MMA(0, 0, At, B0); PG8_BAR; PG8_SCHED;
            PG8_LDB(B1, 0, 1); PG8_STAGE(PG8_SB(0, 0), b2, voffB);
            PG8_BAR; PG8_WAIT_L(0); PG8_MMA(0, 1, At, B1); PG8_BAR;
            PG8_LDA(At, 0, 1); PG8_STAGE(PG8_SA(0, 0), a2, voffA);
            PG8_BAR; PG8_WAIT_L(0); PG8_MMA(1, 0, At, B0); PG8_BAR; PG8_SCHED;
            PG8_STAGE(PG8_SB(0, 1), b2 + hstep, voffB);
            PG8_WAIT_V(6); PG8_BAR; PG8_MMA(1, 1, At, B1); PG8_BAR;
            PG8_LDB(B0, 1, 0); PG8_SCHED; PG8_LDA(At, 1, 0); PG8_STAGE(PG8_SA(0, 1), a2 + hstep, voffA);
            PG8_WAIT_L(8); PG8_BAR; PG8_WAIT_L(0); PG8_MMA(0, 0, At, B0); PG8_BAR; PG8_SCHED;
            PG8_LDB(B1, 1, 1); PG8_STAGE(PG8_SB(1, 0), b3, voffB);
            PG8_BAR; PG8_WAIT_L(0); PG8_MMA(0, 1, At, B1); PG8_BAR;
            PG8_LDA(At, 1, 1); PG8_STAGE(PG8_SA(1, 0), a3, voffA);
            PG8_BAR; PG8_WAIT_L(0); PG8_MMA(1, 0, At, B0); PG8_BAR; PG8_SCHED;
            PG8_STAGE(PG8_SB(1, 1), b3 + hstep, voffB);
            PG8_WAIT_V(6); PG8_BAR; PG8_MMA(1, 1, At, B1); PG8_BAR;
            }
        }
        if constexpr (ALIGN_EPI) { if (wr == 0) PG8_BAR; }
        if constexpr (!Epi::AFTER_DRAIN) { E(acc, cur, wr, wc, fr, fq); S.done(cur); }
        if (!has_next) break;
#pragma unroll
        for (int a = 0; a < 2; ++a)
#pragma unroll
            for (int b = 0; b < 2; ++b)
#pragma unroll
                for (int m = 0; m < 4; ++m)
#pragma unroll
                    for (int n = 0; n < 2; ++n) acc[a][b][m][n] = (f32x4){0.f, 0.f, 0.f, 0.f};
        cur = nxt; cA = nA; cB = nB; ++ui;
        if constexpr (ALIGN_EPI) { if (wr == 1) PG8_BAR; }
    }
    PG8_WAIT_V(0);
    if constexpr (!ALIGN_EPI) { if (wr == 0) PG8_BAR; }
    PG8_BAR;
    if constexpr (Epi::AFTER_DRAIN) { E.fused(acc, cur, wr, wc, fr, fq, lds, wid, lane); S.done(cur); }
#undef PG8_SA
#undef PG8_SB
#undef PG8_STAGE
#undef PG8_LDA
#undef PG8_LDB
#undef PG8_MMA
#undef PG8_WAIT_V
#undef PG8_WAIT_L
#undef PG8_BAR
#undef PG8_SCHED
}
}

#define LAS __attribute__((address_space(3)))
typedef unsigned short bf16;
typedef short bf16x8 __attribute__((ext_vector_type(8)));
typedef float f32x4 __attribute__((ext_vector_type(4)));
typedef unsigned u32x4 __attribute__((ext_vector_type(4)));
typedef unsigned u32x2 __attribute__((ext_vector_type(2)));

constexpr int NWAVES = 8, NTHR = 512;
constexpr int D = 2048, SEQ = 8192, CTXL = 256, ML = 16384, MT = 16896;
constexpr int BW = 768, BCOLS = 2688, INC = 6016, INCP = 6144, ZB0 = 1024, ZC0 = 3712, DFF = 8192, NH = 12, SL = 8448;
constexpr int NMOD = 12288;
constexpr float ALPHA = 1.41421356237f;
constexpr float LN_EPS = 1e-5f, GN_EPS = 64e-5f;

constexpr size_t MiB = 1u << 20;
constexpr size_t WS_CTL = 0, CTL_BYTES = 1 * MiB;
constexpr size_t WS_WIN = 1 * MiB, WS_WOUT = 25 * MiB, WS_WUP = 33 * MiB, WS_WDN = 65 * MiB, WS_SMALL = 97 * MiB;
constexpr size_t WS_XC = 99 * MiB, WS_AC = 103 * MiB, WS_Z = 169 * MiB, WS_SOP = 367 * MiB, WS_Y = 590 * MiB, WS_G = 640 * MiB, WS_BV = 665 * MiB, WS_END = 690 * MiB;
constexpr size_t WS_SLAB = 440 * MiB;
constexpr size_t WS_HM = WS_Z;
constexpr size_t SM_W2T = 0, SM_A2T = 98304, SM_G2T = 196608, SM_GMWS = 294912;
constexpr int LDS_BYTES = 147456;

#define LDS_WAIT() asm volatile("s_waitcnt lgkmcnt(0)" ::: "memory")
__device__ __forceinline__ unsigned f2bf(float f) { unsigned u = __builtin_bit_cast(unsigned, f); return (u + 0x7fffu + ((u >> 16) & 1u)) >> 16; }
__device__ __forceinline__ unsigned pk2(float lo, float hi) { return f2bf(lo) | (f2bf(hi) << 16); }
__device__ __forceinline__ float bflo(unsigned w) { return __builtin_bit_cast(float, w << 16); }
__device__ __forceinline__ float bfhi(unsigned w) { return __builtin_bit_cast(float, w & 0xffff0000u); }
__device__ __forceinline__ float bf1(bf16 h) { return __builtin_bit_cast(float, ((unsigned)h) << 16); }
__device__ __forceinline__ float sigmoid_f(float x) { return __builtin_amdgcn_rcpf(1.f + __expf(-x)); }
__device__ __forceinline__ float silu_f(float x) { return x * __builtin_amdgcn_rcpf(1.f + __expf(-x)); }
__device__ __forceinline__ float tanh_f(float x) { const float e = __expf(2.f * x); return 1.f - 2.f * __builtin_amdgcn_rcpf(e + 1.f); }
__device__ __forceinline__ float gelu_f(float x) { const float y = 0.7978845608f * (x + 0.044715f * x * x * x); return 0.5f * x * (1.f + tanh_f(y)); }
__device__ __forceinline__ float wave_sum(float v) {
#pragma unroll
    for (int o = 1; o < 64; o <<= 1) v += __shfl_xor(v, o);
    return v;
}
template <int CTRL> __device__ __forceinline__ float dpp_mov(float x) { return __builtin_bit_cast(float, __builtin_amdgcn_update_dpp(0, __builtin_bit_cast(int, x), CTRL, 0xf, 0xf, true)); }
__device__ __forceinline__ float allreduce16(float x) {
    x += dpp_mov<0x128>(x); x += dpp_mov<0x124>(x); x += dpp_mov<0x122>(x); x += dpp_mov<0x121>(x); return x;
}
#define MFMA16(a, b, c) __builtin_amdgcn_mfma_f32_16x16x32_bf16((a), (b), (c), 0, 0, 0)

template <int ACT> struct EpiStoreBf16 {
    static constexpr bool PERM = true, AFTER_DRAIN = false;
    bf16* O; int ldc;
    __device__ __forceinline__ void operator()(const pg8::f32x4 (&acc)[2][2][4][2], const pg8::Unit& u, int wr, int wc, int fr, int fq) const {
        const int row0 = u.pm * 256 + wr * 64 + fr, col0 = u.pn * 256 + wc * 32 + 8 * fq;
#pragma unroll
        for (int ai = 0; ai < 2; ++ai)
#pragma unroll
            for (int m = 0; m < 4; ++m) { bf16* rowp = O + (size_t)(row0 + ai * 128 + m * 16) * ldc + col0;
#pragma unroll
                for (int bj = 0; bj < 2; ++bj) { pg8::f32x4 v0 = acc[ai][bj][m][0], v1 = acc[ai][bj][m][1];
                    if (ACT == 1) {
#pragma unroll
                        for (int e = 0; e < 4; ++e) { float a = fmaxf(v0[e], 0.f), b = fmaxf(v1[e], 0.f); v0[e] = a * a; v1[e] = b * b; } }
                    u32x4 w; w.x = pg8::cvt_pk_bf16(v0[0], v0[1]); w.y = pg8::cvt_pk_bf16(v0[2], v0[3]); w.z = pg8::cvt_pk_bf16(v1[0], v1[1]); w.w = pg8::cvt_pk_bf16(v1[2], v1[3]);
                    *(u32x4*)(rowp + bj * 128) = w; } }
    }
};
struct EpiRes {
    static constexpr bool PERM = false, AFTER_DRAIN = false;
    const float* srcL; const float* srcC; float* dstL; float* dstC; const float* gate;
    __device__ __forceinline__ void operator()(const pg8::f32x4 (&acc)[2][2][4][2], const pg8::Unit& u, int wr, int wc, int fr, int fq) const {
        const int R0 = u.pm * 256; const float* src; float* dst; int mv;
        if (R0 < ML) { src = srcL + (size_t)R0 * D; dst = dstL + (size_t)R0 * D; mv = (R0 >= SEQ) ? 1 : 0; }
        else { src = srcC + (size_t)(R0 - ML) * D; dst = dstC + (size_t)(R0 - ML) * D; mv = 2; }
        const int col0 = u.pn * 256 + wc * 32 + 4 * fq; const float* gt = gate + mv * NMOD + col0;
        pg8::f32x4 gv[2][2];
#pragma unroll
        for (int bj = 0; bj < 2; ++bj)
#pragma unroll
            for (int n = 0; n < 2; ++n) gv[bj][n] = *(const pg8::f32x4*)(gt + bj * 128 + n * 16);
#pragma unroll
        for (int ai = 0; ai < 2; ++ai)
#pragma unroll
            for (int m = 0; m < 4; ++m) { const size_t off = (size_t)(wr * 64 + fr + ai * 128 + m * 16) * D + col0;
#pragma unroll
                for (int bj = 0; bj < 2; ++bj)
#pragma unroll
                    for (int n = 0; n < 2; ++n) { const pg8::f32x4 s = *(const pg8::f32x4*)(src + off + bj * 128 + n * 16);
                        *(pg8::f32x4*)(dst + off + bj * 128 + n * 16) = s * ALPHA + gv[bj][n] * acc[ai][bj][m][n]; }
                asm volatile("" ::: "memory"); }
    }
};

struct EpiSlabCtx {
    static constexpr bool PERM = false, AFTER_DRAIN = false;
    float* slab; const float* gate; int ldn;
    __device__ __forceinline__ void operator()(const pg8::f32x4 (&acc)[2][2][4][2], const pg8::Unit& u, int wr, int wc, int fr, int fq) const {
        const int col0 = u.pn * 256 + wc * 32 + 4 * fq;
        float* dst = slab + ((size_t)u.ks * (2 * CTXL) + u.pm * 256) * ldn;
#pragma unroll
        for (int bj = 0; bj < 2; ++bj)
#pragma unroll
            for (int n = 0; n < 2; ++n) { const pg8::f32x4 gv = gate ? *(const pg8::f32x4*)(gate + col0 + bj * 128 + n * 16) : (pg8::f32x4){1.f, 1.f, 1.f, 1.f};
#pragma unroll
                for (int ai = 0; ai < 2; ++ai)
#pragma unroll
                    for (int m = 0; m < 4; ++m) *(pg8::f32x4*)(dst + (size_t)(wr * 64 + fr + ai * 128 + m * 16) * ldn + col0 + bj * 128 + n * 16) = gv * acc[ai][bj][m][n]; }
    }
};
struct SplitKOrder {
    int nM, nN, nS, G, c;
    __device__ __forceinline__ bool next(int i, pg8::Unit& u) const { const int L = i * G + c; if (L >= nM * nN * nS) return false; u.ks = L % nS; const int t = L / nS; u.pm = t % nM; u.pn = t / nM; return true; }
    __device__ __forceinline__ void a_ready(const pg8::Unit&) const {}
    __device__ __forceinline__ void done(const pg8::Unit&) const {}
};

__device__ __forceinline__ void transpose_item(const float* W, int K, int N, bf16* WT, int row_off, LAS float* scr, int item, int lane) {
    const int nblk = N / 32, kb = item / nblk, nb = item % nblk, k0 = 64 * kb, n0 = 32 * nb;
#pragma unroll 8
    for (int i = 0; i < 32; ++i) { const int kk = 2 * i + (lane >> 5); scr[kk * 33 + (lane & 31)] = W[(size_t)(k0 + kk) * N + n0 + (lane & 31)]; }
    LDS_WAIT(); asm volatile("" ::: "memory");
    const int c = lane & 7;
#pragma unroll
    for (int j = 0; j < 4; ++j) { const int n = (lane >> 3) + 8 * j; const LAS float* s = scr + (8 * c) * 33 + n;
        u32x4 o; o.x = pk2(s[0 * 33], s[1 * 33]); o.y = pk2(s[2 * 33], s[3 * 33]); o.z = pk2(s[4 * 33], s[5 * 33]); o.w = pk2(s[6 * 33], s[7 * 33]);
        *(u32x4*)(WT + (size_t)(row_off + n0 + n) * K + k0 + 8 * c) = o; }
    LDS_WAIT(); asm volatile("" ::: "memory");
}
struct In { const float* p[28]; };
__device__ __forceinline__ void convert_weights(const In& in, int l, int part, unsigned char* ws, LAS unsigned char* lds, int gw, int NGW, int wave, int lane) {
    LAS float* scr = (LAS float*)(lds + wave * 16384);
    constexpr int I_IN = 32 * 188, I_OUT = 32 * 64, I_UP = 32 * 256, I_DN = 128 * 64, I_L = 24;
    bf16* small = (bf16*)(ws + WS_SMALL);
    if (part == 0 || part == 2 || part == 3) {
        constexpr int NITEMS = I_IN + 4 * I_L + 2 * I_L;
        if (part != 3) for (int it = gw; it < NITEMS; it += NGW) {
            int r = it;
            if (r < I_IN) { transpose_item(in.p[6] + (size_t)l * D * INC, D, INC, (bf16*)(ws + WS_WIN), 0, scr, r, lane); continue; } r -= I_IN;
            if (r < 2 * I_L) { const int d = r / I_L; transpose_item(in.p[11] + (size_t)(l * 2 + d) * 64 * BW, 64, BW, small + SM_W2T + d * BW * 64, 0, scr, r % I_L, lane); continue; } r -= 2 * I_L;
            if (r < 2 * I_L) { const int d = r / I_L; transpose_item(in.p[13] + (size_t)(l * 2 + d) * 64 * BW, 64, BW, small + SM_A2T + d * BW * 64, 0, scr, r % I_L, lane); continue; } r -= 2 * I_L;
            transpose_item(in.p[14] + (size_t)l * 128 * BW, 128, BW, small + SM_G2T, 0, scr, r, lane);
        }
        if (part == 2) return;
        const int gt = gw * 64 + lane, NT = NGW * 64;
        const float* gm = in.p[7] + (size_t)l * 131072;
        for (int i = gt; i < 131072 / 4; i += NT) { const f32x4 v = *(const f32x4*)(gm + 4 * i); u32x2 o; o.x = pk2(v.x, v.y); o.y = pk2(v.z, v.w); *(u32x2*)(small + SM_GMWS + 4 * i) = o; }
        u32x4* padp = (u32x4*)((bf16*)(ws + WS_WIN) + (size_t)INC * D);
        for (int i = gt; i < 128 * D / 8; i += NT) padp[i] = (u32x4){0u, 0u, 0u, 0u};
    } else {
        constexpr int NITEMS = I_OUT + I_UP + I_DN;
        for (int it = gw; it < NITEMS; it += NGW) {
            int r = it;
            if (r < I_OUT) { transpose_item(in.p[21] + (size_t)l * D * D, D, D, (bf16*)(ws + WS_WOUT), 0, scr, r, lane); continue; } r -= I_OUT;
            if (r < I_UP) { transpose_item(in.p[24] + (size_t)l * D * DFF, D, DFF, (bf16*)(ws + WS_WUP), 0, scr, r, lane); continue; } r -= I_UP;
            transpose_item(in.p[25] + (size_t)l * DFF * D, DFF, D, (bf16*)(ws + WS_WDN), 0, scr, r, lane);
        }
    }
}
__device__ __forceinline__ void mod_gemv(const In& in, float* mod, int gw, int NGW, int lane) {
    for (int it = gw; it < 2 * 48 * 16; it += NGW) {
        const int l = it / 768, r = it % 768, cgi = r >> 4, ks = r & 15;
        const float* W = in.p[4] + (size_t)l * D * NMOD + (size_t)(ks * 128) * NMOD + cgi * 256 + lane * 4;
        const float* c0 = in.p[1] + ks * 128; const float* c1 = in.p[1] + D + ks * 128; const float* c2 = in.p[3] + ks * 128;
        f32x4 a0 = {0.f, 0.f, 0.f, 0.f}, a1 = a0, a2 = a0;
#pragma unroll 8
        for (int k = 0; k < 128; ++k) { const f32x4 w = *(const f32x4*)(W + (size_t)k * NMOD);
            const float s0 = silu_f(c0[k]), s1 = silu_f(c1[k]), s2 = silu_f(c2[k]);
            a0 += w * s0; a1 += w * s1; a2 += w * s2; }
        if (ks == 0) { const f32x4 bv = *(const f32x4*)(in.p[5] + (size_t)l * NMOD + cgi * 256 + lane * 4); a0 += bv; a1 += bv; a2 += bv; }
        float* mo = mod + (size_t)l * 3 * NMOD + cgi * 256 + lane * 4;
#pragma unroll
        for (int e = 0; e < 4; ++e) { atomicAdd(mo + e, a0[e]); atomicAdd(mo + NMOD + e, a1[e]); atomicAdd(mo + 2 * NMOD + e, a2[e]); }
    }
}
__device__ __forceinline__ void rowwise(int gw, int NGW, int lane, int nrows, const float* srcL, const float* srcC, float* dstL, float* dstC,
                                        bool do_ln, const float* lng, const float* lnb, bool do_mod, const float* modl, int shc, int scc, bf16* aout, const float* slab = nullptr, int nslab = 0) {
    f32x4 nv[8];
    if (gw < nrows) { const float* s0_ = (gw < ML) ? srcL + (size_t)gw * D : srcC + (size_t)(gw - ML) * D;
#pragma unroll
        for (int j = 0; j < 8; ++j) nv[j] = *(const f32x4*)(s0_ + lane * 4 + 256 * j); }
    for (int m = gw; m < nrows; m += NGW) {
        float* dst; int mv;
        if (m < ML) { dst = dstL + (size_t)m * D; mv = (m >= SEQ) ? 1 : 0; }
        else { dst = dstC + (size_t)(m - ML) * D; mv = 2; }
        f32x4 v[8];
#pragma unroll
        for (int j = 0; j < 8; ++j) v[j] = nv[j];
        { const int mn = m + NGW;
          if (mn < nrows) { const float* s1_ = (mn < ML) ? srcL + (size_t)mn * D : srcC + (size_t)(mn - ML) * D;
#pragma unroll
              for (int j = 0; j < 8; ++j) nv[j] = *(const f32x4*)(s1_ + lane * 4 + 256 * j); } }
        if (nslab > 0 && m >= ML) {
#pragma unroll
            for (int j = 0; j < 8; ++j) v[j] = v[j] * ALPHA;
            for (int sidx = 0; sidx < nslab; ++sidx) { const float* sp = slab + ((size_t)sidx * (2 * CTXL) + (m - ML)) * D + lane * 4;
#pragma unroll
                for (int j = 0; j < 8; ++j) v[j] += *(const f32x4*)(sp + 256 * j); }
        }
        if (do_ln) {
            float s = 0.f;
#pragma unroll
            for (int j = 0; j < 8; ++j) s += (v[j].x + v[j].y) + (v[j].z + v[j].w);
            const float mean = wave_sum(s) * (1.f / D); float s2 = 0.f;
#pragma unroll
            for (int j = 0; j < 8; ++j) { v[j] = v[j] - mean; s2 += (v[j].x * v[j].x + v[j].y * v[j].y) + (v[j].z * v[j].z + v[j].w * v[j].w); }
            const float rstd = rsqrtf(wave_sum(s2) * (1.f / D) + LN_EPS);
#pragma unroll
            for (int j = 0; j < 8; ++j) { const f32x4 gg = *(const f32x4*)(lng + lane * 4 + 256 * j), bb = *(const f32x4*)(lnb + lane * 4 + 256 * j);
                v[j] = v[j] * rstd * gg + bb; *(f32x4*)(dst + lane * 4 + 256 * j) = v[j]; }
        }
        if (do_mod) {
            const float* sh = modl + mv * NMOD + shc * D; const float* sc = modl + mv * NMOD + scc * D;
#pragma unroll
            for (int j = 0; j < 8; ++j) { const f32x4 s1 = *(const f32x4*)(sc + lane * 4 + 256 * j), h1 = *(const f32x4*)(sh + lane * 4 + 256 * j);
                const f32x4 a = v[j] * (s1 + 1.f) + h1; u32x2 o; o.x = pk2(a.x, a.y); o.y = pk2(a.z, a.w);
                *(u32x2*)(aout + (size_t)m * D + lane * 4 + 256 * j) = o; }
        }
    }
}

__device__ __forceinline__ f32x4 bf4(u32x2 w) { return (f32x4){bflo(w.x), bfhi(w.x), bflo(w.y), bfhi(w.y)}; }
__device__ __forceinline__ void rwkv_proj_phase(const bf16* Z, const float* shift, const float* w0, const float* a0, const float* kkp, const float* kap, const float* rkp,
                                                const bf16* w2T, const bf16* a2T, const bf16* g2T, bf16* SOP, bf16* G, bf16* BV, LAS unsigned char* lds, int tid, int wave, int lane) {
    for (int it = blockIdx.x; it < 132 * 3; it += gridDim.x) {
        int fr = lane & 15, g = lane >> 4;
        asm volatile("" : "+v"(fr), "+v"(g));
        const int tt = it / 3, hg = it % 3;
        const int m = tt * 128 + wave * 16 + fr;
        int b, tpos, len, s;
        if (m < ML) { b = m >> 13; tpos = m & 8191; len = SEQ; s = CTXL + tpos; } else { b = (m - ML) >> 8; tpos = (m - ML) & 255; len = CTXL; s = tpos; }
        const bool hp = tpos > 0, hn = tpos < len - 1;
        const long offm = hp ? -(long)INCP : 0, offp = hn ? (long)INCP : 0; const float fm = hp ? 1.f : 0.f, fn = hn ? 1.f : 0.f;
        const bf16* zr = Z + (size_t)m * INCP + ZB0;
        bf16x8 xf[12];
#pragma unroll
        for (int ks = 0; ks < 12; ++ks) {
            const int col = 2304 + 32 * ks + 8 * g;
            const u32x4 c0 = *(const u32x4*)(zr + col), cm = *(const u32x4*)(zr + offm + col), cp = *(const u32x4*)(zr + offp + col);
            float val[8];
#pragma unroll
            for (int q = 0; q < 2; ++q) { const f32x4 t0 = *(const f32x4*)(shift + col + 4 * q) * fm, t1 = *(const f32x4*)(shift + BCOLS + col + 4 * q), t2 = *(const f32x4*)(shift + 2 * BCOLS + col + 4 * q) * fn;
                const unsigned m0 = q ? cm.z : cm.x, m1 = q ? cm.w : cm.y, z0 = q ? c0.z : c0.x, z1 = q ? c0.w : c0.y, p0 = q ? cp.z : cp.x, p1 = q ? cp.w : cp.y;
                val[4 * q + 0] = t0.x * bflo(m0) + t1.x * bflo(z0) + t2.x * bflo(p0);
                val[4 * q + 1] = t0.y * bfhi(m0) + t1.y * bfhi(z0) + t2.y * bfhi(p0);
                val[4 * q + 2] = t0.z * bflo(m1) + t1.z * bflo(z1) + t2.z * bflo(p1);
                val[4 * q + 3] = t0.w * bfhi(m1) + t1.w * bfhi(z1) + t2.w * bfhi(p1); }
#pragma unroll
            for (int e = 0; e < 8; ++e) { if (ks < 4) val[e] = tanh_f(val[e]); else if (ks >= 8) val[e] = sigmoid_f(val[e]); }
            u32x4 pk; pk.x = pk2(val[0], val[1]); pk.y = pk2(val[2], val[3]); pk.z = pk2(val[4], val[5]); pk.w = pk2(val[6], val[7]);
            xf[ks] = __builtin_bit_cast(bf16x8, pk);
            if (ks & 1) asm volatile("" ::: "memory");
        }
#pragma unroll 1
        for (int hh = 0; hh < 4; ++hh) {
            const int h = hg * 4 + hh;
            asm volatile("" : "+v"(fr), "+v"(g));
            __syncthreads();
            {
#pragma unroll 2
                for (int i = 0; i < 6; ++i) { const int cid = tid + 512 * i, tok = cid / 24, ch = cid % 24, wh = ch >> 3, col = wh * BW + h * 64 + (ch & 7) * 8;
                    const int mm = tt * 128 + tok; int tp, ln; if (mm < ML) { tp = mm & 8191; ln = SEQ; } else { tp = (mm - ML) & 255; ln = CTXL; }
                    const bool hp_ = tp > 0, hn_ = tp < ln - 1; const float fm_ = hp_ ? 1.f : 0.f, fn_ = hn_ ? 1.f : 0.f;
                    const bf16* zz = Z + (size_t)mm * INCP + ZB0 + col;
                    const u32x4 c0 = *(const u32x4*)zz, cm = *(const u32x4*)(zz - (hp_ ? INCP : 0)), cp = *(const u32x4*)(zz + (hn_ ? INCP : 0));
                    float val[8];
#pragma unroll
                    for (int qq = 0; qq < 2; ++qq) { const f32x4 t0 = *(const f32x4*)(shift + col + 4 * qq) * fm_, t1 = *(const f32x4*)(shift + BCOLS + col + 4 * qq), t2 = *(const f32x4*)(shift + 2 * BCOLS + col + 4 * qq) * fn_;
                        const unsigned m0 = qq ? cm.z : cm.x, m1 = qq ? cm.w : cm.y, z0 = qq ? c0.z : c0.x, z1 = qq ? c0.w : c0.y, p0 = qq ? cp.z : cp.x, p1 = qq ? cp.w : cp.y;
                        val[4 * qq + 0] = t0.x * bflo(m0) + t1.x * bflo(z0) + t2.x * bflo(p0);
                        val[4 * qq + 1] = t0.y * bfhi(m0) + t1.y * bfhi(z0) + t2.y * bfhi(p0);
                        val[4 * qq + 2] = t0.z * bflo(m1) + t1.z * bflo(z1) + t2.z * bflo(p1);
                        val[4 * qq + 3] = t0.w * bfhi(m1) + t1.w * bfhi(z1) + t2.w * bfhi(p1); }
                    u32x4 pk; pk.x = pk2(val[0], val[1]); pk.y = pk2(val[2], val[3]); pk.z = pk2(val[4], val[5]); pk.w = pk2(val[6], val[7]);
                    *(LAS u32x4*)(lds + tok * 400 + ch * 16) = pk; }
#pragma unroll
                for (int i = 0; i < 6; ++i) { const int cid = tid + 512 * i;
                    if (i < 4) { const int cc = cid & 1023, dd = cc >> 9, n = (cc >> 3) & 63, c8 = cc & 7; const bf16* src = ((i < 2) ? w2T : a2T) + ((size_t)(dd * BW + h * 64 + n) * 64 + c8 * 8);
                        *(LAS u32x4*)(lds + 51200 + ((i < 2) ? 0 : 18432) + (dd * 64 + n) * 144 + c8 * 16) = *(const u32x4*)src; }
                    else { const int cc = cid - 2048, n = cc >> 4, c8 = cc & 15; *(LAS u32x4*)(lds + 51200 + 36864 + n * 272 + c8 * 16) = *(const u32x4*)(g2T + ((size_t)(h * 64 + n) * 128 + c8 * 8)); } }
            }
            __syncthreads();
            const LAS unsigned char* rkv = lds + (wave * 16 + fr) * 400 + 8 * g;
            f32x4 kc[4]; float ss = 0.f;
#pragma unroll
            for (int nb = 0; nb < 4; ++nb) {
                const int c = h * 64 + nb * 16 + 4 * g;
                kc[nb] = bf4(*(const LAS u32x2*)(rkv + 128 + nb * 32));
                const f32x4 t = kc[nb] * *(const f32x4*)(kkp + c);
                ss += (t.x * t.x + t.y * t.y) + (t.z * t.z + t.w * t.w);
            }
            ss += __shfl_xor(ss, 16); ss += __shfl_xor(ss, 32);
            const float inv = rsqrtf(fmaxf(ss, 1e-12f));
            bf16* sp = SOP + ((size_t)((b * NH + h) * SL + s)) * 576 + 4 * g;
            float bon = 0.f;
#pragma unroll
            for (int nb = 0; nb < 4; ++nb) {
                const int n = h * 64 + nb * 16 + fr;
                f32x4 accw[2], acca[2], accg = (f32x4){0.f, 0.f, 0.f, 0.f};
#pragma unroll
                for (int d = 0; d < 2; ++d) { accw[d] = (f32x4){0.f, 0.f, 0.f, 0.f}; acca[d] = (f32x4){0.f, 0.f, 0.f, 0.f};
#pragma unroll
                    for (int ksl = 0; ksl < 2; ++ksl) {
                        const bf16x8 wf = *(const LAS bf16x8*)(lds + 51200 + (d * 64 + nb * 16 + fr) * 144 + (32 * ksl + 8 * g) * 2);
                        const bf16x8 af = *(const LAS bf16x8*)(lds + 51200 + 18432 + (d * 64 + nb * 16 + fr) * 144 + (32 * ksl + 8 * g) * 2);
                        accw[d] = MFMA16(wf, xf[2 * d + ksl], accw[d]);
                        acca[d] = MFMA16(af, xf[4 + 2 * d + ksl], acca[d]); } }
#pragma unroll
                for (int ksl = 0; ksl < 4; ++ksl) { const bf16x8 gf = *(const LAS bf16x8*)(lds + 51200 + 36864 + (nb * 16 + fr) * 272 + (32 * ksl + 8 * g) * 2); accg = MFMA16(gf, xf[8 + ksl], accg); }
                const int c = h * 64 + nb * 16 + 4 * g;
                const f32x4 rc = bf4(*(const LAS u32x2*)(rkv + nb * 32)), vc = bf4(*(const LAS u32x2*)(rkv + 256 + nb * 32));
                const f32x4 w00 = *(const f32x4*)(w0 + c), w01 = *(const f32x4*)(w0 + BW + c), a00 = *(const f32x4*)(a0 + c), a01 = *(const f32x4*)(a0 + BW + c);
                const f32x4 kk4 = *(const f32x4*)(kkp + c), ka4 = *(const f32x4*)(kap + c), rk4 = *(const f32x4*)(rkp + c);
                float o[9][4];
#pragma unroll
                for (int e = 0; e < 4; ++e) {
                    const float ad0 = sigmoid_f(a00[e] + acca[0][e]), ad1 = sigmoid_f(a01[e] + acca[1][e]);
                    const float lw0 = -0.60653066f * sigmoid_f(w00[e] + accw[0][e]), lw1 = -0.60653066f * sigmoid_f(w01[e] + accw[1][e]);
                    const float k = kc[nb][e], kk = k * kk4[e] * inv;
                    const float kd0 = k * (1.f + (ad0 - 1.f) * ka4[e]), kd1 = k * (1.f + (ad1 - 1.f) * ka4[e]);
                    bon += rc[e] * (kd0 + kd1) * rk4[e];
                    o[0][e] = rc[e]; o[1][e] = vc[e]; o[2][e] = -kk; o[3][e] = lw0; o[4][e] = kd0; o[5][e] = kk * ad0; o[6][e] = lw1; o[7][e] = kd1; o[8][e] = kk * ad1;
                }
#pragma unroll
                for (int vv = 0; vv < 9; ++vv) { u32x2 w; w.x = pk2(o[vv][0], o[vv][1]); w.y = pk2(o[vv][2], o[vv][3]); *(u32x2*)(sp + vv * 64 + nb * 16) = w; }
                { u32x2 w; w.x = pk2(accg[0], accg[1]); w.y = pk2(accg[2], accg[3]); *(u32x2*)(G + (size_t)m * BW + c) = w; }
            }
            bon += __shfl_xor(bon, 16); bon += __shfl_xor(bon, 32);
#pragma unroll
            for (int nb = 0; nb < 4; ++nb) { const int c = h * 64 + nb * 16 + 4 * g;
                const f32x4 t = bf4(*(const LAS u32x2*)(rkv + 256 + nb * 32)) * bon;
                u32x2 w; w.x = pk2(t.x, t.y); w.y = pk2(t.z, t.w); *(u32x2*)(BV + (size_t)m * BW + c) = w; }
            asm volatile("" ::: "memory");
        }
    }
}

#ifndef SCAN_NCW
#define SCAN_NCW 4
#endif
constexpr int NCW = SCAN_NCW, RPB = 4 * NCW, BPH = 64 / RPB, SCAN_BLOCKS = 48 * BPH, TT = 32, NTILE = SL / TT;
struct StepOps { f32x4 r, a, w, k, b; float v; };
typedef float f32x2 __attribute__((ext_vector_type(2)));
template <int DIR> __device__ __forceinline__ void scan_tile(const LAS float* opq, const LAS float* opv, LAS float* ybq, f32x2& Sx, f32x2& Sy) {
#define TR(i) (DIR ? (TT - 1 - (i)) : (i))
#define SCAN_LOAD(o, i) do { const LAS float* bp = opq + TR(i) * 384; \
        o.r = *(const LAS f32x4*)(bp); o.a = *(const LAS f32x4*)(bp + 128); o.w = *(const LAS f32x4*)(bp + 192); o.k = *(const LAS f32x4*)(bp + 256); o.b = *(const LAS f32x4*)(bp + 320); \
        o.v = opv[TR(i) * 384]; asm volatile("" ::: "memory"); } while (0)
#define SCAN_STEP(o, i) do { \
        f32x2 t_ = Sx * o.a.lo; t_ = Sy * o.a.hi + t_; float sa = t_.x + t_.y; sa = allreduce16(sa); \
        const f32x2 kx_ = o.k.lo * o.v, ky_ = o.k.hi * o.v; \
        Sx = Sx * o.w.lo + (o.b.lo * sa + kx_); Sy = Sy * o.w.hi + (o.b.hi * sa + ky_); \
        f32x2 u_ = Sx * o.r.lo; u_ = Sy * o.r.hi + u_; float yv_ = u_.x + u_.y; yv_ += dpp_mov<0x128>(yv_); ybq[TR(i) * RPB * 8] = yv_; asm volatile("" ::: "memory"); } while (0)
    StepOps X0, X1, X2, X3;
    SCAN_LOAD(X0, 0); SCAN_LOAD(X1, 1);
#pragma unroll
    for (int i = 0; i < TT; i += 4) {
        SCAN_LOAD(X2, i + 2); SCAN_STEP(X0, i);
        SCAN_LOAD(X3, i + 3); SCAN_STEP(X1, i + 1);
        if (i + 4 < TT) SCAN_LOAD(X0, i + 4);
        SCAN_STEP(X2, i + 2);
        if (i + 4 < TT) SCAN_LOAD(X1, i + 5);
        SCAN_STEP(X3, i + 3);
    }
#undef TR
#undef SCAN_LOAD
#undef SCAN_STEP
}
__device__ __forceinline__ void scan_block(int pair, int part, const bf16* SOP, bf16* Y, LAS unsigned char* lds, int tid, int wave, int lane, int pf = 3) {
    static_assert(NCW == 4, "waves 0-3 compute, waves 4-7 stage operands and write y out");
    const int d = pair / 24, b = (pair % 24) / 12, h = pair % 12;
    LAS float* op0 = (LAS float*)lds;
    LAS float* op1 = (LAS float*)(lds + 49152);
    LAS float* yb0 = (LAS float*)(lds + 98304);
    LAS float* yb1 = (LAS float*)(lds + 98304 + 32 * RPB * 8 * 4);
    const int q = lane & 15, rl = (wave & 3) * 4 + (lane >> 4);
    const bf16* sbase = SOP + (size_t)((b * NH + h) * SL) * 576;
    const int ht = tid - 256, part8 = ht & 7, stok = ht >> 3;
    u32x4 sa_[6], sb_[6];
#define SCAN_S0(j) (d == 0 ? TT * (j) : ((j) < 8 ? CTXL - TT * ((j) + 1) : SL - TT * ((j) - 8 + 1)))
#define SCAN_ISSUE(dst, j) do { const bf16* sp_ = sbase + ((size_t)SCAN_S0(j) + stok) * 576 + part8 * 8; \
        _Pragma("unroll") for (int i = 0; i < 6; ++i) dst[i] = *(const u32x4*)(sp_ + ((i < 3) ? i : 3 + 3 * d + (i - 3)) * 64); } while (0)
#define SCAN_STAGE(src, opb) do { _Pragma("unroll") for (int i = 0; i < 6; ++i) { \
            f32x4 lo = {bflo(src[i].x), bfhi(src[i].x), bflo(src[i].y), bfhi(src[i].y)}, hi = {bflo(src[i].z), bfhi(src[i].z), bflo(src[i].w), bfhi(src[i].w)}; \
            if (i == 3) { lo.x = __expf(lo.x); lo.y = __expf(lo.y); lo.z = __expf(lo.z); lo.w = __expf(lo.w); hi.x = __expf(hi.x); hi.y = __expf(hi.y); hi.z = __expf(hi.z); hi.w = __expf(hi.w); } \
            LAS float* dp = opb + (stok * 6 + i) * 64 + part8 * 8; *(LAS f32x4*)dp = lo; *(LAS f32x4*)(dp + 4) = hi; } } while (0)
#define SCAN_BAR() do { asm volatile("s_waitcnt lgkmcnt(0)" ::: "memory"); __builtin_amdgcn_s_barrier(); asm volatile("" ::: "memory"); } while (0)
#define SCAN_YOUT(ybuf, j) do { const int s0_ = SCAN_S0(j); _Pragma("unroll") for (int i = 0; i < RPB / 8; ++i) { const int idx = ht + 256 * i, tok = idx / RPB, r = idx % RPB; const LAS f32x4* yp = (const LAS f32x4*)(ybuf + idx * 8); \
            const f32x4 t = yp[0] + yp[1]; \
            Y[((size_t)((d * 2 + b) * SL + s0_ + tok)) * BW + h * 64 + part * RPB + r] = (bf16)f2bf((t.x + t.y) + (t.z + t.w)); } } while (0)
#define SCAN_TILE(nxt, j, opc, opn, ybc, ybp) do { \
        if (wave < 4) { if (!(pf & 4)) { \
            if (d == 0) scan_tile<0>(opc + 4 * q, opc + 64 + part * RPB + rl, ybc + rl * 8 + (q & 7), Sx, Sy); \
            else        scan_tile<1>(opc + 4 * q, opc + 64 + part * RPB + rl, ybc + rl * 8 + (q & 7), Sx, Sy); } \
        } else { \
            if ((j) + 1 < NTILE) SCAN_STAGE(nxt, opn); \
            if ((j) + 3 < NTILE) SCAN_ISSUE(nxt, (j) + 3); \
            if ((j) > 0) SCAN_YOUT(ybp, (j) - 1); } \
        SCAN_BAR(); } while (0)
    f32x2 Sx = {0.f, 0.f}, Sy = {0.f, 0.f};
    if (wave < 4) __builtin_amdgcn_s_setprio(3);
    if (wave >= 4) { SCAN_ISSUE(sa_, 0); SCAN_ISSUE(sb_, 1); SCAN_STAGE(sa_, op0); SCAN_ISSUE(sa_, 2); }
    SCAN_BAR();
#pragma unroll 1
    for (int j = 0; j < NTILE; j += 2) { SCAN_TILE(sb_, j, op0, op1, yb0, yb1); SCAN_TILE(sa_, j + 1, op1, op0, yb1, yb0); }
    __builtin_amdgcn_s_setprio(0);
    if (wave >= 4) SCAN_YOUT(yb1, NTILE - 1);
    __syncthreads();
#undef SCAN_TILE
#undef SCAN_YOUT
#undef SCAN_BAR
#undef SCAN_STAGE
#undef SCAN_S0
#undef SCAN_ISSUE
}

constexpr int KSTR = 72;
__device__ __forceinline__ void na_item(int item, const bf16* Z, const float* rpb, bf16* CC, LAS unsigned char* lds, int tid, int wave, int lane) {
    LAS bf16* Ks = (LAS bf16*)lds;
    LAS bf16* Vt = (LAS bf16*)(lds + 9216);
    LAS float* rp = (LAS float*)(lds + 18432);
    const int fr = lane & 15, g = lane >> 4;
    int b, h, is_ctx, qrow, ustart = 0, nloc = 0; size_t mq;
    if (item < 1536) { is_ctx = 0; b = item / 768; const int r = item % 768; h = r / 64; const int rpi = r % 64; const int ri0 = 2 * rpi;
        qrow = ri0 + (wave >> 2); ustart = min(max(ri0 - 4, 0), 120); nloc = min(max(ri0 + 1 - 4, 0), 120) + 8 - ustart;
        mq = (size_t)b * SEQ + qrow * 64 + (wave & 3) * 16 + fr; }
    else { is_ctx = 1; const int r = item - 1536; b = r / 24; h = (r % 24) >> 1; const int p = r & 1; qrow = 0;
        mq = (size_t)ML + b * CTXL + (2 * p + (wave >> 2)) * 64 + (wave & 3) * 16 + fr; }
    const int ci = (wave & 3) * 16 + fr;
    const int wstart = min(max(qrow - 4, 0), 120);
    const int cs = min(max(ci - 8, 0), 48);
    __syncthreads();
    if (!is_ctx) for (int i = tid; i < 465; i += NTHR) rp[i] = rpb[h * 465 + i];
    bf16x8 qf[2];
#pragma unroll
    for (int ks = 0; ks < 2; ++ks) qf[ks] = *(const bf16x8*)(Z + mq * INCP + ZC0 + h * 64 + 32 * ks + 8 * g);
    const int key = tid >> 3, ch = tid & 7;
    auto krow = [&](int t) -> size_t { return t < 9 ? (size_t)b * SEQ + (ustart + t) * 64 + key : (size_t)ML + b * CTXL + (t - 9) * 64 + key; };
    const int ntl = nloc + 4;
#define NA_TID(p) ((p) < nloc ? (p) : 9 + (p) - nloc)
#define NA_LOAD(kd, vd, p) do { const bf16* zp_ = Z + krow(NA_TID(p)) * INCP + ZC0 + h * 64 + ch * 8; kd = *(const u32x4*)(zp_ + 768); vd = *(const u32x4*)(zp_ + 1536); } while (0)
    u32x4 k0 = {0u, 0u, 0u, 0u}, v0 = k0, k1 = k0, v1 = k0, k2 = k0, v2 = k0;
    NA_LOAD(k0, v0, 0); NA_LOAD(k1, v1, 1); NA_LOAD(k2, v2, 2);
    int doff[4][4]; float madd[4][4];
#pragma unroll
    for (int nb = 0; nb < 4; ++nb)
#pragma unroll
        for (int e = 0; e < 4; ++e) { const int ck = nb * 16 + 4 * g + e; doff[nb][e] = min(max(ck - ci + 15, 0), 30); madd[nb][e] = ((ck >= cs) && (ck < cs + 16)) ? 0.f : -1e30f; }
    const int qblk = wave & 3, nlo = (qblk >= 2) ? qblk - 1 : 0, nhi = (qblk <= 1) ? qblk + 1 : 3;
    float mrun = -1e30f, lrun = 0.f;
    f32x4 oacc[4];
#pragma unroll
    for (int nb = 0; nb < 4; ++nb) oacc[nb] = (f32x4){0.f, 0.f, 0.f, 0.f};
    for (int p = 0; p < ntl; ++p) {
        const int t = NA_TID(p);
        __syncthreads();
        *(LAS u32x4*)(Ks + key * KSTR + ch * 8) = k0;
        { const unsigned w[4] = {v0.x, v0.y, v0.z, v0.w};
#pragma unroll
          for (int e = 0; e < 4; ++e) { Vt[(ch * 8 + 2 * e) * KSTR + key] = (bf16)(w[e] & 0xffffu); Vt[(ch * 8 + 2 * e + 1) * KSTR + key] = (bf16)(w[e] >> 16); } }
        __syncthreads();
        k0 = k1; v0 = v1; k1 = k2; v1 = v2;
        if (p + 3 < ntl) NA_LOAD(k2, v2, p + 3);
        const int br = ustart + t;
        const bool active = (t >= 9) || (br >= wstart && br < wstart + 8);
        if (active) {
            const bool loc = t < 9;
            f32x4 sc[4];
            float mt = -1e30f;
            const int dr31 = (br - qrow + 7) * 31;
#pragma unroll
            for (int nb = 0; nb < 4; ++nb) {
                const bool nbon = !loc || (nb >= nlo && nb <= nhi);
                sc[nb] = (f32x4){0.f, 0.f, 0.f, 0.f};
                if (nbon) {
#pragma unroll
                    for (int ks = 0; ks < 2; ++ks) { const bf16x8 kf = *(const LAS bf16x8*)(Ks + (nb * 16 + fr) * KSTR + 32 * ks + 8 * g); sc[nb] = MFMA16(kf, qf[ks], sc[nb]); }
                    if (loc) {
#pragma unroll
                        for (int e = 0; e < 4; ++e) { const float v = (sc[nb][e] * 0.125f + rp[dr31 + doff[nb][e]]) + madd[nb][e]; sc[nb][e] = v; mt = fmaxf(mt, v); }
                    } else {
#pragma unroll
                        for (int e = 0; e < 4; ++e) { const float v = sc[nb][e] * 0.125f; sc[nb][e] = v; mt = fmaxf(mt, v); }
                    }
                }
            }
            mt = fmaxf(mt, __shfl_xor(mt, 16)); mt = fmaxf(mt, __shfl_xor(mt, 32));
            const float mnew = fmaxf(mrun, mt), alpha = __expf(mrun - mnew); mrun = mnew;
            float ps = 0.f;
#pragma unroll
            for (int nb = 0; nb < 4; ++nb) {
                const bool nbon = !loc || (nb >= nlo && nb <= nhi);
                if (nbon) {
#pragma unroll
                    for (int e = 0; e < 4; ++e) { const float pp = __expf(sc[nb][e] - mnew); sc[nb][e] = pp; ps += pp; }
                } else sc[nb] = (f32x4){0.f, 0.f, 0.f, 0.f};
            }
            lrun = lrun * alpha + ps;
            bf16x8 pf[2];
#pragma unroll
            for (int ks = 0; ks < 2; ++ks) { u32x4 w; w.x = pk2(sc[2 * ks][0], sc[2 * ks][1]); w.y = pk2(sc[2 * ks][2], sc[2 * ks][3]); w.z = pk2(sc[2 * ks + 1][0], sc[2 * ks + 1][1]); w.w = pk2(sc[2 * ks + 1][2], sc[2 * ks + 1][3]);
                pf[ks] = __builtin_bit_cast(bf16x8, w); }
#pragma unroll
            for (int nb = 0; nb < 4; ++nb) oacc[nb] = oacc[nb] * alpha;
#pragma unroll
            for (int ks = 0; ks < 2; ++ks) {
                const bool kson = !loc || (2 * ks + 1 >= nlo && 2 * ks <= nhi);
                if (kson) {
#pragma unroll
                    for (int nb = 0; nb < 4; ++nb) { const LAS bf16* vp = Vt + (nb * 16 + fr) * KSTR + 32 * ks + 4 * g;
                        const u32x2 lo = *(const LAS u32x2*)vp, hi = *(const LAS u32x2*)(vp + 16);
                        u32x4 w; w.x = lo.x; w.y = lo.y; w.z = hi.x; w.w = hi.y;
                        oacc[nb] = MFMA16(__builtin_bit_cast(bf16x8, w), pf[ks], oacc[nb]); }
                }
            }
        }
    }
#undef NA_TID
#undef NA_LOAD
    lrun += __shfl_xor(lrun, 16); lrun += __shfl_xor(lrun, 32);
    const float il = 1.f / lrun;
    bf16* op = CC + mq * D + 1280 + h * 64 + 4 * g;
#pragma unroll
    for (int nb = 0; nb < 4; ++nb) { u32x2 w; w.x = pk2(oacc[nb][0] * il, oacc[nb][1] * il); w.y = pk2(oacc[nb][2] * il, oacc[nb][3] * il); *(u32x2*)(op + nb * 16) = w; }
}

constexpr int VSTR = 136;
__device__ __forceinline__ void gmlp_item(int item, const bf16* Z, const bf16* gmws, const float* gmbs, bf16* CC, LAS unsigned char* lds, int tid, int wave, int lane) {
    LAS bf16* vt = (LAS bf16*)lds;
    const int cidx = item >> 3, gi = item & 7, fr = lane & 15, g = lane >> 4;
    __syncthreads();
    { const int j = tid >> 2, part = tid & 3; const bf16* zp = Z + (size_t)(cidx * 128 + j) * INCP + 512 + gi * 64 + 16 * part;
      const u32x4 a = *(const u32x4*)zp, bq = *(const u32x4*)(zp + 8);
      float x[16]; const unsigned w[8] = {a.x, a.y, a.z, a.w, bq.x, bq.y, bq.z, bq.w};
      float s = 0.f;
#pragma unroll
      for (int e = 0; e < 8; ++e) { x[2 * e] = gelu_f(bflo(w[e])); x[2 * e + 1] = gelu_f(bfhi(w[e])); s += x[2 * e] + x[2 * e + 1]; }
      s += __shfl_xor(s, 1); s += __shfl_xor(s, 2); const float mu = s * (1.f / 64.f); float s2 = 0.f;
#pragma unroll
      for (int e = 0; e < 16; ++e) { x[e] -= mu; s2 += x[e] * x[e]; }
      s2 += __shfl_xor(s2, 1); s2 += __shfl_xor(s2, 2); const float rstd = rsqrtf(s2 * (1.f / 64.f) + LN_EPS);
#pragma unroll
      for (int e = 0; e < 16; ++e) vt[(16 * part + e) * VSTR + j] = (bf16)f2bf(x[e] * rstd); }
    __syncthreads();
    f32x4 acc[4];
#pragma unroll
    for (int nb = 0; nb < 4; ++nb) acc[nb] = (f32x4){0.f, 0.f, 0.f, 0.f};
    const int i = wave * 16 + fr;
#pragma unroll
    for (int ks = 0; ks < 4; ++ks) { const bf16x8 wf = *(const bf16x8*)(gmws + (size_t)(gi * 128 + i) * 128 + 32 * ks + 8 * g);
#pragma unroll
        for (int nb = 0; nb < 4; ++nb) { const bf16x8 vf = *(const LAS bf16x8*)(vt + (nb * 16 + fr) * VSTR + 32 * ks + 8 * g); acc[nb] = MFMA16(vf, wf, acc[nb]); } }
    const float bs = gmbs[gi * 128 + i];
    const size_t m = (size_t)cidx * 128 + i;
#pragma unroll
    for (int nb = 0; nb < 4; ++nb) { const int c = nb * 16 + 4 * g; const f32x4 u = bf4(*(const u32x2*)(Z + m * INCP + gi * 64 + c));
        u32x2 w; w.x = pk2(gelu_f(u.x) * (acc[nb][0] + bs), gelu_f(u.y) * (acc[nb][1] + bs)); w.y = pk2(gelu_f(u.z) * (acc[nb][2] + bs), gelu_f(u.w) * (acc[nb][3] + bs));
        *(u32x2*)(CC + m * D + gi * 64 + c) = w; }
}

__device__ __forceinline__ void rwkv_out_phase(int nrows, const bf16* Y, const bf16* G, const bf16* BV, const float* gng, const float* gnb, bf16* CC, int tid) {
    const int l16 = tid & 15;
    for (int gi = (blockIdx.x * NTHR + tid) >> 4; gi < nrows * NH; gi += (gridDim.x * NTHR) >> 4) {
        const int m = gi / NH, h = gi % NH; int b, s;
        if (m < ML) { b = m >> 13; s = CTXL + (m & 8191); } else { b = (m - ML) >> 8; s = (m - ML) & 255; }
        const int c = h * 64 + 4 * l16;
        const f32x4 y0 = bf4(*(const u32x2*)(Y + ((size_t)(b * SL + s)) * BW + c)), y1 = bf4(*(const u32x2*)(Y + ((size_t)((2 + b) * SL + s)) * BW + c));
        f32x4 y = y0 + y1;
        float sm = (y.x + y.y) + (y.z + y.w);
#pragma unroll
        for (int o = 1; o < 16; o <<= 1) sm += __shfl_xor(sm, o);
        const float mu = sm * (1.f / 64.f); y = y - mu;
        float s2 = (y.x * y.x + y.y * y.y) + (y.z * y.z + y.w * y.w);
#pragma unroll
        for (int o = 1; o < 16; o <<= 1) s2 += __shfl_xor(s2, o);
        const float rstd = rsqrtf(s2 * (1.f / 64.f) + GN_EPS);
        const f32x4 gg = *(const f32x4*)(gng + c), gb = *(const f32x4*)(gnb + c);
        const f32x4 bv = bf4(*(const u32x2*)(BV + (size_t)m * BW + c)), gt = bf4(*(const u32x2*)(G + (size_t)m * BW + c));
        const f32x4 o = (y * rstd * gg + gb + bv) * gt;
        u32x2 w; w.x = pk2(o.x, o.y); w.y = pk2(o.z, o.w);
        *(u32x2*)(CC + (size_t)m * D + 512 + c) = w;
    }
}

#ifndef PER_PHASE_LAUNCH
#define PER_PHASE_LAUNCH 0
#endif
#ifndef PH_MASK
#define PH_MASK 0x7ff
#endif
#define PHON(k) ((PH_MASK >> (k)) & 1)
#ifndef NA_EARLY
#define NA_EARLY 580
#endif
#ifndef WGM_N2048
#define WGM_N2048 4
#endif
#ifndef WGM_N8192
#define WGM_N8192 4
#endif
constexpr int N_PHASES = 21;
struct Args { In in; float* out; unsigned char* ws; int ph_lo, ph_hi; };
#define XB_TMO      128
#define XB_XCNT(j)  (256  + 64 * (j))
#define XB_XSUB(j)  (1280 + 64 * (j))
#define XB_XGEN(j)  (2304 + 64 * (j))
#define XB_TOP      3328
#define XB_TOPGEN   3392
#define XCD_BAR_WORDS 3456
#define XB_SPIN_CAP (1u << 18)

__device__ __forceinline__ unsigned xb_ld(unsigned* p)              { return __hip_atomic_load(p, __ATOMIC_RELAXED, __HIP_MEMORY_SCOPE_AGENT); }
__device__ __forceinline__ unsigned xb_add(unsigned* p, unsigned v) { return __hip_atomic_fetch_add(p, v, __ATOMIC_RELAXED, __HIP_MEMORY_SCOPE_AGENT); }
__device__ __forceinline__ unsigned xb_xcc_id() { return (unsigned)__builtin_amdgcn_s_getreg((3 << 11) | 20) & 0xFu; }
#define XB_SPIN(cond, bar) do { unsigned _sp = 0; while (cond) { __builtin_amdgcn_s_sleep(1); \
    if ((++_sp & 255u) == 0u) { if (xb_ld(&(bar)[XB_TMO])) break; if (_sp > XB_SPIN_CAP) { atomicAdd(&(bar)[XB_TMO], 1u); break; } } } } while (0)

struct XcdBarrier {
    unsigned* bar; unsigned x;
    volatile LAS unsigned* st;
};

__device__ __forceinline__ XcdBarrier xcd_barrier_post(unsigned* bar, volatile LAS unsigned* st) {
    XcdBarrier b; b.bar = bar; b.x = xb_xcc_id(); b.st = st;
    if (threadIdx.x == 0) (void)xb_add(&bar[XB_XCNT(b.x)], 1u);
    return b;
}
__device__ __forceinline__ void xcd_barrier_complete(unsigned* bar, unsigned x, unsigned& nloc, unsigned& nx) {
    const unsigned G = gridDim.x * gridDim.y * gridDim.z;
    unsigned sum, cnt, mine, sp = 0u;
    for (;;) {
        sum = 0u; cnt = 0u; mine = 0u;
#pragma unroll
        for (unsigned j = 0; j < 16; ++j) { const unsigned c = xb_ld(&bar[XB_XCNT(j)]); sum += c; cnt += (c > 0u) ? 1u : 0u; mine = (j == x) ? c : mine; }
        if (sum == G) break;
        __builtin_amdgcn_s_sleep(1);
        if ((++sp & 255u) == 0u) { if (xb_ld(&bar[XB_TMO])) break; if (sp > XB_SPIN_CAP) { atomicAdd(&bar[XB_TMO], 1u); break; } }
    }
    nloc = mine > 0u ? mine : 1u; nx = cnt > 0u ? cnt : 1u;
}

__device__ __forceinline__ void xcd_barrier(const XcdBarrier& b) {
    asm volatile("s_waitcnt vmcnt(0)" ::: "memory");
    __syncthreads();
    if (threadIdx.x == 0) {
        unsigned* bar = b.bar;
        __builtin_amdgcn_s_waitcnt(0);
        unsigned nloc = b.st[0], nx = b.st[1];
        if (nloc == 0u) { xcd_barrier_complete(bar, b.x, nloc, nx); b.st[0] = nloc; b.st[1] = nx; }
        const unsigned old = xb_add(&bar[XB_XSUB(b.x)], 1u);
        const unsigned gen = old / nloc;
        if (old + 1u == (gen + 1u) * nloc) {
            __builtin_amdgcn_fence(__ATOMIC_RELEASE, "agent");
            asm volatile("s_waitcnt vmcnt(0)" ::: "memory");
            const unsigned og = xb_add(&bar[XB_TOP], 1u);
            const unsigned tg = og / nx;
            if (og + 1u == (tg + 1u) * nx) xb_add(&bar[XB_TOPGEN], 1u);
            else XB_SPIN(xb_ld(&bar[XB_TOPGEN]) == tg, bar);
            __builtin_amdgcn_fence(__ATOMIC_ACQUIRE, "agent");
            xb_add(&bar[XB_XGEN(b.x)], 1u);
            asm volatile("s_waitcnt vmcnt(0)" ::: "memory");
        } else {
            XB_SPIN(xb_ld(&bar[XB_XGEN(b.x)]) == gen, bar);
            __builtin_amdgcn_fence(__ATOMIC_ACQUIRE, "agent");
            asm volatile("s_waitcnt vmcnt(0)" ::: "memory");
        }
    }
    __syncthreads();
}

constexpr size_t WS_BAR = WS_CTL + 512 * 1024;
constexpr int LDS_BARW = LDS_BYTES - 64;

template <int PH> __device__ __forceinline__ void run_phase(const Args& args, LAS unsigned char* lds, int part = 3) {
    const int tid = threadIdx.x, lane = tid & 63, wave = __builtin_amdgcn_readfirstlane(tid >> 6);
    const int gw = blockIdx.x * NWAVES + wave, NGW = gridDim.x * NWAVES;
    const In& in = args.in;
    unsigned char* ws = args.ws;
    float* mod = (float*)(ws + WS_CTL);
    bf16* small = (bf16*)(ws + WS_SMALL);
    float* XC = (float*)(ws + WS_XC); float* XL = args.out;
    bf16* AC = (bf16*)(ws + WS_AC); bf16* Z = (bf16*)(ws + WS_Z);
    if constexpr (PH == 0) {
        if (PHON(10)) { mod_gemv(in, mod, gw, NGW, lane); convert_weights(in, 0, 0, ws, lds, gw, NGW, wave, lane); }
    } else {
        constexpr int l = (PH - 1) / 10, sub = (PH - 1) % 10;
        const float* modl = mod + (size_t)l * 3 * NMOD;
        constexpr int Mrows = (l == 0) ? MT : ML;
        if constexpr (sub == 0) {
            if (l == 0 && PHON(0)) rowwise(gw, NGW, lane, MT, in.p[0], in.p[2], XL, XC, false, in.p[22], in.p[23], true, modl, 0, 1, AC);
        } else if constexpr (sub == 1) { if (PHON(1)) {
            pg8::Gemm g{AC, (bf16*)(ws + WS_WIN), ML, INCP, D}; pg8::StaticOrder S; S.init(ML, INCP, (int)gridDim.x, (int)blockIdx.x);
            EpiStoreBf16<0> E{Z, INCP};
            pg8::gemm_phase<EpiStoreBf16<0>, pg8::StaticOrder, true, true>(lds, g, S, E); }
        } else if constexpr (sub == 2) { if (PHON(2)) {
            rwkv_proj_phase(Z, in.p[9] + (size_t)l * 3 * BCOLS, in.p[10] + (size_t)l * 2 * BW, in.p[12] + (size_t)l * 2 * BW, in.p[15] + (size_t)l * BW, in.p[16] + (size_t)l * BW,
                            in.p[17] + (size_t)l * BW, small + SM_W2T, small + SM_A2T, small + SM_G2T, (bf16*)(ws + WS_SOP), (bf16*)(ws + WS_G), (bf16*)(ws + WS_BV), lds, tid, wave, lane);
            if ((int)blockIdx.x >= 140) for (int it = (int)blockIdx.x - 140; it < NA_EARLY; it += (int)gridDim.x - 140) na_item(it, Z, in.p[20] + (size_t)l * NH * 465, AC, lds, tid, wave, lane); }
        } else if constexpr (sub == 3) { if (PHON(3)) {
            if ((int)blockIdx.x < SCAN_BLOCKS) { if (part & 1) {
                const int blk = blockIdx.x, x = blk & 7, slot = blk >> 3, pair = x + 8 * (slot / BPH), quarter = slot % BPH;
                scan_block(pair, quarter, (const bf16*)(ws + WS_SOP), (bf16*)(ws + WS_Y), lds, tid, wave, lane, part); }
            } else if (part & 2) {
                constexpr int nNA = (l == 0) ? 1584 : 1536, nG = (l == 0) ? 1056 : 1024;
                for (int it = NA_EARLY + (int)blockIdx.x - SCAN_BLOCKS; it < nNA + nG; it += (int)gridDim.x - SCAN_BLOCKS) {
                    if (it < nNA) na_item(it, Z, in.p[20] + (size_t)l * NH * 465, AC, lds, tid, wave, lane);
                    else gmlp_item(it - nNA, Z, small + SM_GMWS, in.p[8] + (size_t)l * 1024, AC, lds, tid, wave, lane);
                }
                __syncthreads();
                convert_weights(in, l, 1, ws, lds, ((int)blockIdx.x - SCAN_BLOCKS) * NWAVES + wave, ((int)gridDim.x - SCAN_BLOCKS) * NWAVES, wave, lane);
            } }
        } else if constexpr (sub == 4) { if (PHON(4)) {
            rwkv_out_phase(Mrows, (const bf16*)(ws + WS_Y), (const bf16*)(ws + WS_G), (const bf16*)(ws + WS_BV), in.p[18] + (size_t)l * BW, in.p[19] + (size_t)l * BW, AC, tid); }
        } else if constexpr (sub == 5) { if (PHON(5)) {
            pg8::Gemm g{AC, (bf16*)(ws + WS_WOUT), ML, D, D}; pg8::StaticOrder S; S.init(ML, D, (int)gridDim.x, (int)blockIdx.x, WGM_N2048);
            EpiRes E{(l == 0) ? in.p[0] : (const float*)XL, (l == 0) ? in.p[2] : (const float*)XC, XL, XC, modl + 2 * D};
            pg8::gemm_phase<EpiRes, pg8::StaticOrder, true, true>(lds, g, S, E); }
        } else if constexpr (sub == 6) { if (PHON(6)) {
            rowwise(gw, NGW, lane, Mrows, XL, (l == 0) ? in.p[2] : (const float*)XC, XL, XC, true, in.p[22] + (size_t)l * D, in.p[23] + (size_t)l * D, true, modl, 3, 4, AC, (const float*)(ws + WS_SLAB), (l == 0) ? 8 : 0); }
        } else if constexpr (sub == 7) { if (PHON(7)) {
            pg8::Gemm g{AC, (bf16*)(ws + WS_WUP), Mrows, DFF, D}; pg8::StaticOrder S; S.init(Mrows, DFF, (int)gridDim.x, (int)blockIdx.x, WGM_N8192);
            EpiStoreBf16<1> E{(bf16*)(ws + WS_HM), DFF};
            pg8::gemm_phase<EpiStoreBf16<1>, pg8::StaticOrder, true, true>(lds, g, S, E); }
        } else if constexpr (sub == 8) { if (PHON(8)) {
            pg8::Gemm g{(bf16*)(ws + WS_HM), (bf16*)(ws + WS_WDN), ML, D, DFF}; pg8::StaticOrder S; S.init(ML, D, (int)gridDim.x, (int)blockIdx.x, WGM_N2048);
            EpiRes E{XL, XC, XL, XC, modl + 5 * D};
            pg8::gemm_phase<EpiRes, pg8::StaticOrder, true, true>(lds, g, S, E); }
        } else { if (PHON(9)) {
            rowwise(gw, NGW, lane, Mrows, XL, XC, XL, XC, true, in.p[26] + (size_t)l * D, in.p[27] + (size_t)l * D, l == 0, modl + 3 * NMOD, 0, 1, AC, (const float*)(ws + WS_SLAB), (l == 0) ? 16 : 0);
            if (l == 0) { __syncthreads(); convert_weights(in, 1, 0, ws, lds, gw, NGW, wave, lane); } }
        }
    }
}
template <int PH> __device__ __forceinline__ void run_ctx(const Args& args, LAS unsigned char* lds) {
    unsigned char* ws = args.ws;
    if constexpr (PH == 6 || PH == 9) {
        const float* modl = (const float*)(ws + WS_CTL);
        const int KS = (PH == 6) ? 256 : 512, LDK = (PH == 6) ? D : DFF, NS = (PH == 6) ? 8 : 16;
        const bf16* A = (PH == 6) ? (const bf16*)(ws + WS_AC) + (size_t)ML * D : (const bf16*)(ws + WS_HM) + (size_t)ML * DFF;
        const bf16* W = (PH == 6) ? (const bf16*)(ws + WS_WOUT) : (const bf16*)(ws + WS_WDN);
        pg8::Gemm g2{A, W, 2 * CTXL, D, KS, LDK}; SplitKOrder S2{2, 8, NS, (int)gridDim.x, (int)blockIdx.x};
        EpiSlabCtx E2{(float*)(ws + WS_SLAB), modl + 2 * NMOD + ((PH == 6) ? 2 : 5) * D, D};
        pg8::gemm_phase<EpiSlabCtx, SplitKOrder, true, true>(lds, g2, S2, E2);
    } else if constexpr (PH == 2 || PH == 12) {
        pg8::Gemm g2{(const bf16*)(ws + WS_AC) + (size_t)ML * D, (const bf16*)(ws + WS_WIN), 2 * CTXL, INCP, 512, D}; SplitKOrder S2{2, 24, 4, (int)gridDim.x, (int)blockIdx.x};
        EpiSlabCtx E2{(float*)(ws + WS_SLAB), nullptr, INCP};
        pg8::gemm_phase<EpiSlabCtx, SplitKOrder, true, true>(lds, g2, S2, E2);
    }
}
__device__ __forceinline__ void hctx_sum(const Args& args) {
    const float* slab = (const float*)(args.ws + WS_SLAB); bf16* H = (bf16*)(args.ws + WS_HM) + (size_t)ML * DFF;
    constexpr int NG = 2 * CTXL * DFF / 4; constexpr size_t SS = (size_t)2 * CTXL * DFF;
    for (int i = blockIdx.x * NTHR + threadIdx.x; i < NG; i += gridDim.x * NTHR) {
        f32x4 v = (*(const f32x4*)(slab + 4 * (size_t)i) + *(const f32x4*)(slab + SS + 4 * (size_t)i)) + (*(const f32x4*)(slab + 2 * SS + 4 * (size_t)i) + *(const f32x4*)(slab + 3 * SS + 4 * (size_t)i));
        v.x = fmaxf(v.x, 0.f); v.y = fmaxf(v.y, 0.f); v.z = fmaxf(v.z, 0.f); v.w = fmaxf(v.w, 0.f); v = v * v;
        u32x2 o; o.x = pk2(v.x, v.y); o.y = pk2(v.z, v.w); *(u32x2*)(H + 4 * (size_t)i) = o; }
}
__device__ __forceinline__ void zctx_sum(const Args& args) {
    const float* slab = (const float*)(args.ws + WS_SLAB); bf16* Z = (bf16*)(args.ws + WS_Z) + (size_t)ML * INCP;
    constexpr int NG = 2 * CTXL * INCP / 4; constexpr size_t SS = (size_t)2 * CTXL * INCP;
    for (int i = blockIdx.x * NTHR + threadIdx.x; i < NG; i += gridDim.x * NTHR) {
        const f32x4 v = (*(const f32x4*)(slab + 4 * (size_t)i) + *(const f32x4*)(slab + SS + 4 * (size_t)i)) + (*(const f32x4*)(slab + 2 * SS + 4 * (size_t)i) + *(const f32x4*)(slab + 3 * SS + 4 * (size_t)i));
        u32x2 o; o.x = pk2(v.x, v.y); o.y = pk2(v.z, v.w); *(u32x2*)(Z + 4 * (size_t)i) = o; }
}
__global__ void __launch_bounds__(NTHR, 2) fwd_megakernel(Args args) {
    extern __shared__ __attribute__((aligned(16))) unsigned char lds_raw[];
    LAS unsigned char* lds = (LAS unsigned char*)lds_raw;
    cg::grid_group grid = cg::this_grid();
    const int lo = args.ph_lo, hi = args.ph_hi;
    if (threadIdx.x < 16) ((LAS unsigned*)(lds + LDS_BARW))[threadIdx.x] = 0u;
    __syncthreads();
    const XcdBarrier xbar = xcd_barrier_post((unsigned*)(args.ws + WS_BAR), (volatile LAS unsigned*)(lds + LDS_BARW));
#define GRID_SYNC(PH) do { if ((PH) == 0) grid.sync(); else xcd_barrier(xbar); } while (0)
#ifndef REP_PART
#define REP_PART 3
#endif
#ifndef REP_MASK
#define REP_MASK 0
#endif
#define REPON(PH) ((PH) > 0 && ((REP_MASK >> (((PH) - 1) % 10)) & 1))
#define DO(PH) if (lo <= (PH) && (PH) < hi) { if (REPON(PH)) { if (REP_PART != 64) run_phase<PH>(args, lds, REP_PART); if ((PH) == 0) grid.sync(); else xcd_barrier(xbar); } run_phase<PH>(args, lds); run_ctx<PH>(args, lds); if ((PH) == 2 || (PH) == 12) { xcd_barrier(xbar); zctx_sum(args); } if ((PH) + 1 < hi) GRID_SYNC(PH); }
    DO(0) DO(1) DO(2) DO(3) DO(4) DO(5) DO(6) DO(7) DO(8) DO(9) DO(10)
    DO(11) DO(12) DO(13) DO(14) DO(15) DO(16) DO(17) DO(18) DO(19) DO(20)
#undef DO
}

extern "C" void kernel_launch(void* const* d_in, const int* in_sizes, int n_in, void* d_out, int out_size, void* d_ws, size_t ws_size, hipStream_t stream) {
    static int grid = 0;
    if (grid == 0) {
        if (n_in != 28 || ws_size < WS_END) { fprintf(stderr, "kernel_launch: unexpected n_in %d / ws_size %zu (need %zu)\n", n_in, ws_size, (size_t)WS_END); grid = -1; return; }
        int dev = 0, cus = 0;
        if (hipGetDevice(&dev) != hipSuccess || hipDeviceGetAttribute(&cus, hipDeviceAttributeMultiprocessorCount, dev) != hipSuccess) { grid = -1; return; }
        if (hipFuncSetAttribute((const void*)fwd_megakernel, hipFuncAttributeMaxDynamicSharedMemorySize, LDS_BYTES) != hipSuccess) { fprintf(stderr, "kernel_launch: hipFuncSetAttribute failed\n"); grid = -1; return; }
        grid = cus;
    }
    if (grid < 0) return;
    (void)hipMemsetAsync((char*)d_ws + WS_CTL, 0, CTL_BYTES, stream);
    Args a{};
    for (int i = 0; i < 28; ++i) a.in.p[i] = (const float*)d_in[i];
    a.out = (float*)d_out; a.ws = (unsigned char*)d_ws;
#if PER_PHASE_LAUNCH
    for (int ph = 0; ph < N_PHASES; ++ph) { a.ph_lo = ph; a.ph_hi = ph + 1; hipLaunchKernelGGL(fwd_megakernel, dim3(grid), dim3(NTHR), LDS_BYTES, stream, a); }
#else
    a.ph_lo = 0; a.ph_hi = N_PHASES;
    void* kargs[] = {&a};
    hipError_t e = hipLaunchCooperativeKernel((const void*)fwd_megakernel, dim3(grid), dim3(NTHR), kargs, LDS_BYTES, stream);
    if (e != hipSuccess) fprintf(stderr, "cooperative launch failed: %s (grid %d)\n", hipGetErrorString(e), grid);
#endif
}
```

```cpp
#include <hip/hip_runtime.h>
#include <hip/hip_cooperative_groups.h>
#include <cstdio>
#include <cstdint>
namespace cg = cooperative_groups;
#define NA_EARLY 464
namespace pg8 {
#define PG8_LAS __attribute__((address_space(3)))
typedef unsigned short bf16_t;
typedef short bf16x8 __attribute__((ext_vector_type(8)));
typedef float f32x4 __attribute__((ext_vector_type(4)));
typedef unsigned u32x4 __attribute__((ext_vector_type(4)));
constexpr int BM = 256, BK = 64, HALF = 128, HTB = HALF * BK * 2  , STAGE_BYTES = 8 * HTB, NXCD = 8, WGM = 8;

__host__ __device__ __forceinline__ int lds_byte(int r, int c) { const int st = (r >> 4) * 2 + (c >> 5), rr = r & 15, cc = c & 31, ob = rr * 64 + cc * 2; return st * 1024 + (ob ^ (((ob >> 9) & 1) << 5)); }
__host__ __device__ __forceinline__ void stage_rc(int b, int& R, int& C) { const int st = b / 1024, sb = b % 1024, swz = sb ^ (((sb >> 9) & 1) << 5); R = (st >> 1) * 16 + swz / 64; C = (st & 1) * 32 + (swz % 64) / 2; }
__host__ __device__ __forceinline__ int perm32(int rho) { const int n = rho >> 4, i = rho & 15; return 8 * (i >> 2) + 4 * n + (i & 3); }

struct Unit { int pm, pn, ks; };
struct Gemm { const bf16_t* A; const bf16_t* Bt; int M, N, K; int ld = 0; };

struct StaticOrder {
    int nM, nN, nwg, G, c, wgm;
    __host__ __device__ void init(int M, int N, int G_, int c_, int wgm_ = WGM) { nM = M / BM; nN = N / BM; nwg = nM * nN; G = G_; c = c_; wgm = wgm_; }
    __host__ __device__ bool next(int i, Unit& u) const {
        const long L = (long)i * G + c; if (L >= nwg) return false;
        int wgid = (int)L; { const int q = nwg / NXCD, r = nwg % NXCD, xcd = wgid % NXCD, off = wgid / NXCD; wgid = (xcd < r ? xcd * (q + 1) : r * (q + 1) + (xcd - r) * q) + off; }
        const int nig = wgm * nN, gid = wgid / nig, fm = gid * wgm, gsz = (nM - fm) < wgm ? (nM - fm) : wgm;
        u.pm = fm + ((wgid % nig) % gsz); u.pn = (wgid % nig) / gsz; u.ks = 0; return true;
    }
    __device__ __forceinline__ void a_ready(const Unit&) const {}
    __device__ __forceinline__ void done(const Unit&) const {}
};

__device__ __forceinline__ unsigned cvt_pk_bf16(float lo, float hi) { unsigned r; asm volatile("v_cvt_pk_bf16_f32 %0, %1, %2" : "=v"(r) : "v"(lo), "v"(hi)); return r; }
typedef float f32x2 __attribute__((ext_vector_type(2)));
__device__ __forceinline__ f32x2 gelu_pk(f32x2 v) {
    const f32x2 av = __builtin_elementwise_abs(v), d = av * 0.2316418882f + 1.0f;
    f32x2 t; t.x = __builtin_amdgcn_rcpf(d.x); t.y = __builtin_amdgcn_rcpf(d.y);
    f32x2 q = t * 0.5307027145f + (-0.7265760135f); q = q * t + 0.7107068705f; q = q * t + (-0.142248368f); q = q * t + 0.127414796f; q = q * t;
    const f32x2 s = (v * v) * (-0.72134752044f);
    f32x2 e; e.x = __builtin_amdgcn_exp2f(s.x); e.y = __builtin_amdgcn_exp2f(s.y);
    const f32x2 m = v * (q * e), r = v - m;
    f32x2 o; o.x = v.x < 0.f ? m.x : r.x; o.y = v.y < 0.f ? m.y : r.y; return o;
}

template <int ACT  > struct EpiBf16 {
    static constexpr bool PERM = true, AFTER_DRAIN = false; static_assert(ACT == 0 || ACT == 1, "EpiBf16: ACT is 0 (none) or 1 (gelu_pk)");
    bf16_t* O; int ldc; const float* bias; int split_cols; size_t split_stride; float scale0;
    __device__ __forceinline__ void operator()(const f32x4 (&acc)[2][2][4][2], const Unit& u, int wr, int wc, int fr, int fq) const {
        const int row0 = u.pm * BM + wr * 64 + fr; int colt = u.pn * BM; bf16_t* base = O;
        float sc = 1.f; if (split_cols) { const int t = colt / split_cols; base += (size_t)t * split_stride; colt -= t * split_cols; if (t == 0) sc = scale0; }
        const int col0 = colt + wc * 32 + 8 * fq, bcol0 = u.pn * BM + wc * 32 + 8 * fq;
        f32x4 bv[2][2];
#pragma unroll
        for (int bj = 0; bj < 2; ++bj)
#pragma unroll
            for (int n = 0; n < 2; ++n) bv[bj][n] = bias ? *(const f32x4*)(bias + bcol0 + bj * HALF + 4 * n) : (f32x4){0.f, 0.f, 0.f, 0.f};
#pragma unroll
        for (int ai = 0; ai < 2; ++ai)
#pragma unroll
            for (int m = 0; m < 4; ++m) { bf16_t* rowp = base + (size_t)(row0 + ai * HALF + m * 16) * ldc + col0;
#pragma unroll
                for (int bj = 0; bj < 2; ++bj) { f32x4 v0 = acc[ai][bj][m][0] + bv[bj][0], v1 = acc[ai][bj][m][1] + bv[bj][1];
                    if (ACT == 1) { f32x2 a = gelu_pk((f32x2){v0[0], v0[1]}), b = gelu_pk((f32x2){v0[2], v0[3]}), c = gelu_pk((f32x2){v1[0], v1[1]}), d = gelu_pk((f32x2){v1[2], v1[3]});
                        v0 = (f32x4){a.x, a.y, b.x, b.y}; v1 = (f32x4){c.x, c.y, d.x, d.y}; }
                    v0 = v0 * sc; v1 = v1 * sc; u32x4 w; w.x = cvt_pk_bf16(v0[0], v0[1]); w.y = cvt_pk_bf16(v0[2], v0[3]); w.z = cvt_pk_bf16(v1[0], v1[1]); w.w = cvt_pk_bf16(v1[2], v1[3]);
                    *(u32x4*)(rowp + bj * HALF) = w; } }
    }
};

template <class Epi, class Sched, bool ALIGN_EPI = false, bool SP2 = false>
__device__ __forceinline__ void gemm_phase(PG8_LAS unsigned char* lds, const Gemm g, const Sched& S, const Epi& E) {
    const int tid = threadIdx.x, wid = __builtin_amdgcn_readfirstlane(tid >> 6), lane = tid & 63, wr = wid >> 2, wc = wid & 3, fr = lane & 15, fq = lane >> 4;
    const int K = g.K, nt = K / BK, LD = g.ld ? g.ld : g.K;
    unsigned voffA[2], voffB[2];
#pragma unroll
    for (int i = 0; i < 2; ++i) { int R, C; stage_rc(tid * 16 + i * 8192, R, C); const int Rb = Epi::PERM ? ((R & ~31) + perm32(R & 31)) : R;
        voffA[i] = (unsigned)(R * LD + C) * 2u; voffB[i] = (unsigned)(Rb * LD + C) * 2u; }
    const size_t kstep = (size_t)(BK * 2);
    const size_t hstep = (size_t)HALF * LD * 2;
    const size_t tstep = 2 * hstep;
    const unsigned ldsw = (unsigned)wid * 1024u;
    const int aoff = lds_byte(wr * 64 + fr, fq * 8), boff = lds_byte(wc * 32 + fr, fq * 8);
#define PG8_SA(b, h) (((b) * 2 + (h)) * HTB)
#define PG8_SB(b, h) ((4 + (b) * 2 + (h)) * HTB)
#define PG8_STAGE(bufoff, gbase, voff) do { _Pragma("unroll") for (int _i = 0; _i < 2; ++_i) \
        __builtin_amdgcn_global_load_lds((const unsigned*)((const char*)(gbase) + (voff)[_i]), (PG8_LAS unsigned*)(lds + (bufoff) + ldsw + _i * 8192), 16, 0, 0); } while (0)
#define PG8_LDA(dst, b, h) do { _Pragma("unroll") for (int m = 0; m < 4; ++m) _Pragma("unroll") for (int k = 0; k < 2; ++k) dst[m][k] = *(const PG8_LAS bf16x8*)(lds + PG8_SA(b, h) + aoff + m * 2048 + k * 1024); } while (0)
#define PG8_LDB(dst, b, h) do { _Pragma("unroll") for (int n = 0; n < 2; ++n) _Pragma("unroll") for (int k = 0; k < 2; ++k) dst[n][k] = *(const PG8_LAS bf16x8*)(lds + PG8_SB(b, h) + boff + n * 2048 + k * 1024); } while (0)
#define PG8_MMA(ai, bj, At, Bt) do { __builtin_amdgcn_s_setprio(1); _Pragma("unroll") for (int m = 0; m < 4; ++m) _Pragma("unroll") for (int n = 0; n < 2; ++n) _Pragma("unroll") for (int k = 0; k < 2; ++k) \
        acc[ai][bj][m][n] = __builtin_amdgcn_mfma_f32_16x16x32_bf16(Bt[n][k], At[m][k], acc[ai][bj][m][n], 0, 0, 0); __builtin_amdgcn_s_setprio(0); } while (0)
#define PG8_WAIT_V(n) asm volatile("s_waitcnt vmcnt(" #n ")" ::: "memory")
#define PG8_WAIT_L(n) asm volatile("s_waitcnt lgkmcnt(" #n ")" ::: "memory")
#define PG8_BAR __builtin_amdgcn_s_barrier()
#define PG8_SCHED __builtin_amdgcn_sched_barrier(0)
    Unit cur, nxt; int ui = 0;
    if (!S.next(0, cur)) return;
    f32x4 acc[2][2][4][2];
#pragma unroll
    for (int a = 0; a < 2; ++a)
#pragma unroll
        for (int b = 0; b < 2; ++b)
#pragma unroll
            for (int m = 0; m < 4; ++m)
#pragma unroll
                for (int n = 0; n < 2; ++n) acc[a][b][m][n] = (f32x4){0.f, 0.f, 0.f, 0.f};
    bf16x8 At[4][2], B0[2][2], B1[2][2];
    const char* cA = (const char*)g.A + (size_t)cur.pm * tstep + (size_t)cur.ks * K * 2; const char* cB = (const char*)g.Bt + (size_t)cur.pn * tstep + (size_t)cur.ks * K * 2;
    S.a_ready(cur);
    if constexpr (SP2) {
        PG8_STAGE(PG8_SB(0, 0), cB, voffB); PG8_STAGE(PG8_SB(0, 1), cB + hstep, voffB); PG8_STAGE(PG8_SA(0, 0), cA, voffA); PG8_STAGE(PG8_SA(0, 1), cA + hstep, voffA);
        if (wr == 1) PG8_BAR;
        PG8_WAIT_V(2); PG8_BAR;
        PG8_STAGE(PG8_SB(1, 0), cB + kstep, voffB); PG8_STAGE(PG8_SA(1, 0), cA + kstep, voffA); PG8_STAGE(PG8_SB(1, 1), cB + hstep + kstep, voffB);
        PG8_WAIT_V(6); PG8_BAR;
    } else {
        PG8_STAGE(PG8_SB(0, 0), cB, voffB); PG8_STAGE(PG8_SA(0, 0), cA, voffA); PG8_STAGE(PG8_SB(0, 1), cB + hstep, voffB); PG8_STAGE(PG8_SA(0, 1), cA + hstep, voffA);
        if (wr == 1) PG8_BAR;
        PG8_WAIT_V(4); PG8_BAR;
        PG8_STAGE(PG8_SB(1, 0), cB + kstep, voffB); PG8_STAGE(PG8_SA(1, 0), cA + kstep, voffA); PG8_STAGE(PG8_SB(1, 1), cB + hstep + kstep, voffB);
        PG8_WAIT_V(6); PG8_BAR;
    }
    for (;;) {
        const bool has_next = S.next(ui + 1, nxt);
        const char* nA = has_next ? (const char*)g.A + (size_t)nxt.pm * tstep + (size_t)nxt.ks * K * 2 : cA; const char* nB = has_next ? (const char*)g.Bt + (size_t)nxt.pn * tstep + (size_t)nxt.ks * K * 2 : cB;
        for (int t = 0; t < nt; t += 2) {
            const bool last = (t == nt - 2);
            const char* a1 = cA + (size_t)(t + 1) * kstep;
            const char* a2 = last ? nA : cA + (size_t)(t + 2) * kstep; const char* b2 = last ? nB : cB + (size_t)(t + 2) * kstep;
            const char* a3 = a2 + kstep; const char* b3 = b2 + kstep;
            if (last && has_next) S.a_ready(nxt);
            if constexpr (SP2) {
            PG8_LDB(B0, 0, 0); PG8_LDB(B1, 0, 1); PG8_SCHED; PG8_LDA(At, 0, 0); PG8_STAGE(PG8_SA(1, 1), a1 + hstep, voffA);
            PG8_WAIT_V(8); PG8_WAIT_L(0); PG8_BAR; PG8_MMA(0, 0, At, B0); PG8_MMA(0, 1, At, B1); PG8_BAR; PG8_SCHED;
            PG8_LDA(At, 0, 1); PG8_STAGE(PG8_SB(0, 0), b2, voffB); PG8_STAGE(PG8_SB(0, 1), b2 + hstep, voffB); PG8_STAGE(PG8_SA(0, 0), a2, voffA);
            PG8_WAIT_V(8); PG8_WAIT_L(0); PG8_BAR; PG8_MMA(1, 0, At, B0); PG8_MMA(1, 1, At, B1); PG8_BAR; PG8_SCHED;
            PG8_LDB(B0, 1, 0); PG8_LDB(B1, 1, 1); PG8_SCHED; PG8_LDA(At, 1, 0); PG8_STAGE(PG8_SA(0, 1), a2 + hstep, voffA);
            PG8_WAIT_V(8); PG8_WAIT_L(0); PG8_BAR; PG8_MMA(0, 0, At, B0); PG8_MMA(0, 1, At, B1); PG8_BAR; PG8_SCHED;
            PG8_LDA(At, 1, 1); PG8_STAGE(PG8_SB(1, 0), b3, voffB); PG8_STAGE(PG8_SB(1, 1), b3 + hstep, voffB); PG8_STAGE(PG8_SA(1, 0), a3, voffA);
            PG8_WAIT_V(8); PG8_WAIT_L(0); PG8_BAR; PG8_MMA(1, 0, At, B0); PG8_MMA(1, 1, At, B1); PG8_BAR; PG8_SCHED;
            } else {
            PG8_LDB(B0, 0, 0); PG8_SCHED; PG8_LDA(At, 0, 0); PG8_STAGE(PG8_SA(1, 1), a1 + hstep, voffA);
            PG8_WAIT_L(8); PG8_BAR; PG8_WAIT_L(0); PG8_MMA(0, 0, At, B0); PG8_BAR; PG8_SCHED;
            PG8_LDB(B1, 0, 1); PG8_STAGE(PG8_SB(0, 0), b2, voffB);
            PG8_BAR; PG8_WAIT_L(0); PG8_MMA(0, 1, At, B1); PG8_BAR;
            PG8_LDA(At, 0, 1); PG8_STAGE(PG8_SA(0, 0), a2, voffA);
            PG8_BAR; PG8_WAIT_L(0); PG8_MMA(1, 0, At, B0); PG8_BAR; PG8_SCHED;
            PG8_STAGE(PG8_SB(0, 1), b2 + hstep, voffB);
            PG8_WAIT_V(6); PG8_BAR; PG8_MMA(1, 1, At, B1); PG8_BAR;
            PG8_LDB(B0, 1, 0); PG8_SCHED; PG8_LDA(At, 1, 0); PG8_STAGE(PG8_SA(0, 1), a2 + hstep, voffA);
            PG8_WAIT_L(8); PG8_BAR; PG8_WAIT_L(0); PG8_MMA(0, 0, At, B0); PG8_BAR; PG8_SCHED;
            PG8_LDB(B1, 1, 1); PG8_STAGE(PG8_SB(1, 0), b3, voffB);
            PG8_BAR; PG8_WAIT_L(0); PG8_MMA(0, 1, At, B1); PG8_BAR;
            PG8_LDA(At, 1, 1); PG8_STAGE(PG8_SA(1, 0), a3, voffA);
            PG8_BAR; PG8_WAIT_L(0); PG8_MMA(1, 0, At, B0); PG8_BAR; PG8_SCHED;
            PG8_STAGE(PG8_SB(1, 1), b3 + hstep, voffB);
            PG8_WAIT_V(6); PG8_BAR; PG8_MMA(1, 1, At, B1); PG8_BAR;
            }
        }
        if constexpr (ALIGN_EPI) { if (wr == 0) PG8_BAR; }
        if constexpr (!Epi::AFTER_DRAIN) { E(acc, cur, wr, wc, fr, fq); S.done(cur); }
        if (!has_next) break;
#pragma unroll
        for (int a = 0; a < 2; ++a)
#pragma unroll
            for (int b = 0; b < 2; ++b)
#pragma unroll
                for (int m = 0; m < 4; ++m)
#pragma unroll
                    for (int n = 0; n < 2; ++n) acc[a][b][m][n] = (f32x4){0.f, 0.f, 0.f, 0.f};
        cur = nxt; cA = nA; cB = nB; ++ui;
        if constexpr (ALIGN_EPI) { if (wr == 1) PG8_BAR; }
    }
    PG8_WAIT_V(0);
    if constexpr (!ALIGN_EPI) { if (wr == 0) PG8_BAR; }
    PG8_BAR;
    if constexpr (Epi::AFTER_DRAIN) { E.fused(acc, cur, wr, wc, fr, fq, lds, wid, lane); S.done(cur); }
#undef PG8_SA
#undef PG8_SB
#undef PG8_STAGE
#undef PG8_LDA
#undef PG8_LDB
#undef PG8_MMA
#undef PG8_WAIT_V
#undef PG8_WAIT_L
#undef PG8_BAR
#undef PG8_SCHED
}
}

#define LAS __attribute__((address_space(3)))
typedef unsigned short bf16;
typedef short bf16x8 __attribute__((ext_vector_type(8)));
typedef float f32x4 __attribute__((ext_vector_type(4)));
typedef unsigned u32x4 __attribute__((ext_vector_type(4)));
typedef unsigned u32x2 __attribute__((ext_vector_type(2)));

constexpr int NWAVES = 8, NTHR = 512;
constexpr int D = 2048, SEQ = 8192, CTXL = 256, ML = 16384, MT = 16896;
constexpr int BW = 768, BCOLS = 2688, INC = 6016, INCP = 6144, ZB0 = 1024, ZC0 = 3712, DFF = 8192, NH = 12, SL = 8448;
constexpr int NMOD = 12288;
constexpr float ALPHA = 1.41421356237f;
constexpr float LN_EPS = 1e-5f, GN_EPS = 64e-5f;

constexpr size_t MiB = 1u << 20;
constexpr size_t WS_CTL = 0, CTL_BYTES = 352 * 1024;
constexpr size_t WS_WIN = 1 * MiB, WS_WOUT = 25 * MiB, WS_WUP = 33 * MiB, WS_WDN = 65 * MiB, WS_SMALL = 97 * MiB;
constexpr size_t WS_XC = 99 * MiB, WS_AC = 103 * MiB, WS_Z = 169 * MiB, WS_SOP = 367 * MiB, WS_Y = 590 * MiB, WS_G = 640 * MiB, WS_BV = 665 * MiB, WS_END = 690 * MiB;
constexpr size_t WS_SLAB = 440 * MiB;
constexpr size_t WS_HM = WS_Z;
constexpr size_t SM_W2T = 0, SM_A2T = 98304, SM_G2T = 196608, SM_GMWS = 294912;
constexpr int LDS_BYTES = 147456;

#define LDS_WAIT() asm volatile("s_waitcnt lgkmcnt(0)" ::: "memory")
__device__ __forceinline__ unsigned f2bf(float f) { unsigned u = __builtin_bit_cast(unsigned, f); return (u + 0x7fffu + ((u >> 16) & 1u)) >> 16; }
__device__ __forceinline__ unsigned pk2(float lo, float hi) { return f2bf(lo) | (f2bf(hi) << 16); }
__device__ __forceinline__ float bflo(unsigned w) { return __builtin_bit_cast(float, w << 16); }
__device__ __forceinline__ float bfhi(unsigned w) { return __builtin_bit_cast(float, w & 0xffff0000u); }
__device__ __forceinline__ float bf1(bf16 h) { return __builtin_bit_cast(float, ((unsigned)h) << 16); }
__device__ __forceinline__ float sigmoid_f(float x) { return __builtin_amdgcn_rcpf(1.f + __expf(-x)); }
__device__ __forceinline__ float silu_f(float x) { return x * __builtin_amdgcn_rcpf(1.f + __expf(-x)); }
__device__ __forceinline__ float tanh_f(float x) { const float e = __expf(2.f * x); return 1.f - 2.f * __builtin_amdgcn_rcpf(e + 1.f); }
__device__ __forceinline__ float gelu_f(float x) { const float y = 0.7978845608f * (x + 0.044715f * x * x * x); return 0.5f * x * (1.f + tanh_f(y)); }
__device__ __forceinline__ float wave_sum(float v) {
#pragma unroll
    for (int o = 1; o < 64; o <<= 1) v += __shfl_xor(v, o);
    return v;
}
template <int CTRL> __device__ __forceinline__ float dpp_mov(float x) { return __builtin_bit_cast(float, __builtin_amdgcn_update_dpp(0, __builtin_bit_cast(int, x), CTRL, 0xf, 0xf, true)); }
__device__ __forceinline__ float allreduce16(float x) {
    x += dpp_mov<0x128>(x); x += dpp_mov<0x124>(x); x += dpp_mov<0x122>(x); x += dpp_mov<0x121>(x); return x;
}
#define MFMA16(a, b, c) __builtin_amdgcn_mfma_f32_16x16x32_bf16((a), (b), (c), 0, 0, 0)

template <int ACT> struct EpiStoreBf16 {
    static constexpr bool PERM = true, AFTER_DRAIN = false;
    bf16* O; int ldc;
    __device__ __forceinline__ void operator()(const pg8::f32x4 (&acc)[2][2][4][2], const pg8::Unit& u, int wr, int wc, int fr, int fq) const {
        const int row0 = u.pm * 256 + wr * 64 + fr, col0 = u.pn * 256 + wc * 32 + 8 * fq;
#pragma unroll
        for (int ai = 0; ai < 2; ++ai)
#pragma unroll
            for (int m = 0; m < 4; ++m) { bf16* rowp = O + (size_t)(row0 + ai * 128 + m * 16) * ldc + col0;
#pragma unroll
                for (int bj = 0; bj < 2; ++bj) { pg8::f32x4 v0 = acc[ai][bj][m][0], v1 = acc[ai][bj][m][1];
                    if (ACT == 1) {
#pragma unroll
                        for (int e = 0; e < 4; ++e) { float a = fmaxf(v0[e], 0.f), b = fmaxf(v1[e], 0.f); v0[e] = a * a; v1[e] = b * b; } }
                    u32x4 w; w.x = pg8::cvt_pk_bf16(v0[0], v0[1]); w.y = pg8::cvt_pk_bf16(v0[2], v0[3]); w.z = pg8::cvt_pk_bf16(v1[0], v1[1]); w.w = pg8::cvt_pk_bf16(v1[2], v1[3]);
                    *(u32x4*)(rowp + bj * 128) = w; } }
    }
};
struct EpiRes {
    static constexpr bool PERM = false, AFTER_DRAIN = false;
    const float* srcL; const float* srcC; float* dstL; float* dstC; const float* gate;
    __device__ __forceinline__ void operator()(const pg8::f32x4 (&acc)[2][2][4][2], const pg8::Unit& u, int wr, int wc, int fr, int fq) const {
        const int R0 = u.pm * 256; const float* src; float* dst; int mv;
        if (R0 < ML) { src = srcL + (size_t)R0 * D; dst = dstL + (size_t)R0 * D; mv = (R0 >= SEQ) ? 1 : 0; }
        else { src = srcC + (size_t)(R0 - ML) * D; dst = dstC + (size_t)(R0 - ML) * D; mv = 2; }
        const int col0 = u.pn * 256 + wc * 32 + 4 * fq; const float* gt = gate + mv * NMOD + col0;
        pg8::f32x4 gv[2][2];
#pragma unroll
        for (int bj = 0; bj < 2; ++bj)
#pragma unroll
            for (int n = 0; n < 2; ++n) gv[bj][n] = *(const pg8::f32x4*)(gt + bj * 128 + n * 16);
#pragma unroll
        for (int ai = 0; ai < 2; ++ai)
#pragma unroll
            for (int m = 0; m < 4; ++m) { const size_t off = (size_t)(wr * 64 + fr + ai * 128 + m * 16) * D + col0;
#pragma unroll
                for (int bj = 0; bj < 2; ++bj)
#pragma unroll
                    for (int n = 0; n < 2; ++n) { const pg8::f32x4 s = *(const pg8::f32x4*)(src + off + bj * 128 + n * 16);
                        *(pg8::f32x4*)(dst + off + bj * 128 + n * 16) = s * ALPHA + gv[bj][n] * acc[ai][bj][m][n]; }
                asm volatile("" ::: "memory"); }
    }
};

struct EpiSlabCtx {
    static constexpr bool PERM = false, AFTER_DRAIN = false;
    float* slab; const float* gate; int ldn;
    __device__ __forceinline__ void operator()(const pg8::f32x4 (&acc)[2][2][4][2], const pg8::Unit& u, int wr, int wc, int fr, int fq) const {
        const int col0 = u.pn * 256 + wc * 32 + 4 * fq;
        float* dst = slab + ((size_t)u.ks * (2 * CTXL) + u.pm * 256) * ldn;
#pragma unroll
        for (int bj = 0; bj < 2; ++bj)
#pragma unroll
            for (int n = 0; n < 2; ++n) { const pg8::f32x4 gv = gate ? *(const pg8::f32x4*)(gate + col0 + bj * 128 + n * 16) : (pg8::f32x4){1.f, 1.f, 1.f, 1.f};
#pragma unroll
                for (int ai = 0; ai < 2; ++ai)
#pragma unroll
                    for (int m = 0; m < 4; ++m) *(pg8::f32x4*)(dst + (size_t)(wr * 64 + fr + ai * 128 + m * 16) * ldn + col0 + bj * 128 + n * 16) = gv * acc[ai][bj][m][n]; }
    }
};
struct SplitKOrder {
    int nM, nN, nS, G, c;
    __device__ __forceinline__ bool next(int i, pg8::Unit& u) const { const int L = i * G + c; if (L >= nM * nN * nS) return false; u.ks = L % nS; const int t = L / nS; u.pm = t % nM; u.pn = t / nM; return true; }
    __device__ __forceinline__ void a_ready(const pg8::Unit&) const {}
    __device__ __forceinline__ void done(const pg8::Unit&) const {}
};

__device__ __forceinline__ void transpose_item(const float* W, int K, int N, bf16* WT, int row_off, LAS float* scr, int item, int lane) {
    const int nblk = N / 32, kb = item / nblk, nb = item % nblk, k0 = 64 * kb, n0 = 32 * nb;
#pragma unroll 8
    for (int i = 0; i < 32; ++i) { const int kk = 2 * i + (lane >> 5); scr[kk * 33 + (lane & 31)] = W[(size_t)(k0 + kk) * N + n0 + (lane & 31)]; }
    LDS_WAIT(); asm volatile("" ::: "memory");
    const int c = lane & 7;
#pragma unroll
    for (int j = 0; j < 4; ++j) { const int n = (lane >> 3) + 8 * j; const LAS float* s = scr + (8 * c) * 33 + n;
        u32x4 o; o.x = pk2(s[0 * 33], s[1 * 33]); o.y = pk2(s[2 * 33], s[3 * 33]); o.z = pk2(s[4 * 33], s[5 * 33]); o.w = pk2(s[6 * 33], s[7 * 33]);
        *(u32x4*)(WT + (size_t)(row_off + n0 + n) * K + k0 + 8 * c) = o; }
    LDS_WAIT(); asm volatile("" ::: "memory");
}
struct In { const float* p[28]; };
__device__ __forceinline__ void convert_weights(const In& in, int l, int part, unsigned char* ws, LAS unsigned char* lds, int gw, int NGW, int wave, int lane) {
    LAS float* scr = (LAS float*)(lds + wave * 16384);
    constexpr int I_IN = 32 * 188, I_OUT = 32 * 64, I_UP = 32 * 256, I_DN = 128 * 64, I_L = 24;
    bf16* small = (bf16*)(ws + WS_SMALL);
    if (part == 0 || part == 2 || part == 3) {
        constexpr int NITEMS = I_IN + 4 * I_L + 2 * I_L;
        if (part != 3) for (int it = gw; it < NITEMS; it += NGW) {
            int r = it;
            if (r < I_IN) { transpose_item(in.p[6] + (size_t)l * D * INC, D, INC, (bf16*)(ws + WS_WIN), 0, scr, r, lane); continue; } r -= I_IN;
            if (r < 2 * I_L) { const int d = r / I_L; transpose_item(in.p[11] + (size_t)(l * 2 + d) * 64 * BW, 64, BW, small + SM_W2T + d * BW * 64, 0, scr, r % I_L, lane); continue; } r -= 2 * I_L;
            if (r < 2 * I_L) { const int d = r / I_L; transpose_item(in.p[13] + (size_t)(l * 2 + d) * 64 * BW, 64, BW, small + SM_A2T + d * BW * 64, 0, scr, r % I_L, lane); continue; } r -= 2 * I_L;
            transpose_item(in.p[14] + (size_t)l * 128 * BW, 128, BW, small + SM_G2T, 0, scr, r, lane);
        }
        if (part == 2) return;
        const int gt = gw * 64 + lane, NT = NGW * 64;
        const float* gm = in.p[7] + (size_t)l * 131072;
        for (int i = gt; i < 131072 / 4; i += NT) { const f32x4 v = *(const f32x4*)(gm + 4 * i); u32x2 o; o.x = pk2(v.x, v.y); o.y = pk2(v.z, v.w); *(u32x2*)(small + SM_GMWS + 4 * i) = o; }
        u32x4* padp = (u32x4*)((bf16*)(ws + WS_WIN) + (size_t)INC * D);
        for (int i = gt; i < 128 * D / 8; i += NT) padp[i] = (u32x4){0u, 0u, 0u, 0u};
    } else {
        constexpr int NITEMS = I_OUT + I_UP + I_DN;
        for (int it = gw; it < NITEMS; it += NGW) {
            int r = it;
            if (r < I_OUT) { transpose_item(in.p[21] + (size_t)l * D * D, D, D, (bf16*)(ws + WS_WOUT), 0, scr, r, lane); continue; } r -= I_OUT;
            if (r < I_UP) { transpose_item(in.p[24] + (size_t)l * D * DFF, D, DFF, (bf16*)(ws + WS_WUP), 0, scr, r, lane); continue; } r -= I_UP;
            transpose_item(in.p[25] + (size_t)l * DFF * D, DFF, D, (bf16*)(ws + WS_WDN), 0, scr, r, lane);
        }
    }
}
__device__ __forceinline__ void mod_gemv(const In& in, float* mod, int gw, int NGW, int lane) {
    for (int it = gw; it < 2 * 48 * 16; it += NGW) {
        const int l = it / 768, r = it % 768, cgi = r >> 4, ks = r & 15;
        const float* W = in.p[4] + (size_t)l * D * NMOD + (size_t)(ks * 128) * NMOD + cgi * 256 + lane * 4;
        const float* c0 = in.p[1] + ks * 128; const float* c1 = in.p[1] + D + ks * 128; const float* c2 = in.p[3] + ks * 128;
        f32x4 a0 = {0.f, 0.f, 0.f, 0.f}, a1 = a0, a2 = a0;
#pragma unroll 8
        for (int k = 0; k < 128; ++k) { const f32x4 w = *(const f32x4*)(W + (size_t)k * NMOD);
            const float s0 = silu_f(c0[k]), s1 = silu_f(c1[k]), s2 = silu_f(c2[k]);
            a0 += w * s0; a1 += w * s1; a2 += w * s2; }
        if (ks == 0) { const f32x4 bv = *(const f32x4*)(in.p[5] + (size_t)l * NMOD + cgi * 256 + lane * 4); a0 += bv; a1 += bv; a2 += bv; }
        float* mo = mod + (size_t)l * 3 * NMOD + cgi * 256 + lane * 4;
#pragma unroll
        for (int e = 0; e < 4; ++e) { atomicAdd(mo + e, a0[e]); atomicAdd(mo + NMOD + e, a1[e]); atomicAdd(mo + 2 * NMOD + e, a2[e]); }
    }
}
__device__ __forceinline__ void rowwise(int gw, int NGW, int lane, int nrows, const float* srcL, const float* srcC, float* dstL, float* dstC,
                                        bool do_ln, const float* lng, const float* lnb, bool do_mod, const float* modl, int shc, int scc, bf16* aout, const float* slab = nullptr, int nslab = 0) {
    f32x4 nv[8];
    if (gw < nrows) { const float* s0_ = (gw < ML) ? srcL + (size_t)gw * D : srcC + (size_t)(gw - ML) * D;
#pragma unroll
        for (int j = 0; j < 8; ++j) nv[j] = *(const f32x4*)(s0_ + lane * 4 + 256 * j); }
    for (int m = gw; m < nrows; m += NGW) {
        float* dst; int mv;
        if (m < ML) { dst = dstL + (size_t)m * D; mv = (m >= SEQ) ? 1 : 0; }
        else { dst = dstC + (size_t)(m - ML) * D; mv = 2; }
        f32x4 v[8];
#pragma unroll
        for (int j = 0; j < 8; ++j) v[j] = nv[j];
        { const int mn = m + NGW;
          if (mn < nrows) { const float* s1_ = (mn < ML) ? srcL + (size_t)mn * D : srcC + (size_t)(mn - ML) * D;
#pragma unroll
              for (int j = 0; j < 8; ++j) nv[j] = *(const f32x4*)(s1_ + lane * 4 + 256 * j); } }
        if (nslab > 0 && m >= ML) {
#pragma unroll
            for (int j = 0; j < 8; ++j) v[j] = v[j] * ALPHA;
            for (int sidx = 0; sidx < nslab; ++sidx) { const float* sp = slab + ((size_t)sidx * (2 * CTXL) + (m - ML)) * D + lane * 4;
#pragma unroll
                for (int j = 0; j < 8; ++j) v[j] += *(const f32x4*)(sp + 256 * j); }
        }
        if (do_ln) {
            float s = 0.f;
#pragma unroll
            for (int j = 0; j < 8; ++j) s += (v[j].x + v[j].y) + (v[j].z + v[j].w);
            const float mean = wave_sum(s) * (1.f / D); float s2 = 0.f;
#pragma unroll
            for (int j = 0; j < 8; ++j) { v[j] = v[j] - mean; s2 += (v[j].x * v[j].x + v[j].y * v[j].y) + (v[j].z * v[j].z + v[j].w * v[j].w); }
            const float rstd = rsqrtf(wave_sum(s2) * (1.f / D) + LN_EPS);
#pragma unroll
            for (int j = 0; j < 8; ++j) { const f32x4 gg = *(const f32x4*)(lng + lane * 4 + 256 * j), bb = *(const f32x4*)(lnb + lane * 4 + 256 * j);
                v[j] = v[j] * rstd * gg + bb; *(f32x4*)(dst + lane * 4 + 256 * j) = v[j]; }
        }
        if (do_mod) {
            const float* sh = modl + mv * NMOD + shc * D; const float* sc = modl + mv * NMOD + scc * D;
#pragma unroll
            for (int j = 0; j < 8; ++j) { const f32x4 s1 = *(const f32x4*)(sc + lane * 4 + 256 * j), h1 = *(const f32x4*)(sh + lane * 4 + 256 * j);
                const f32x4 a = v[j] * (s1 + 1.f) + h1; u32x2 o; o.x = pk2(a.x, a.y); o.y = pk2(a.z, a.w);
                *(u32x2*)(aout + (size_t)m * D + lane * 4 + 256 * j) = o; }
        }
    }
}

__device__ __forceinline__ f32x4 bf4(u32x2 w) { return (f32x4){bflo(w.x), bfhi(w.x), bflo(w.y), bfhi(w.y)}; }
__device__ __forceinline__ void rwkv_proj_phase(const bf16* Z, const float* shift, const float* w0, const float* a0, const float* kkp, const float* kap, const float* rkp,
                                                const bf16* w2T, const bf16* a2T, const bf16* g2T, bf16* SOP, bf16* G, bf16* BV, LAS unsigned char* lds, int tid, int wave, int lane) {
    for (int it = blockIdx.x; it < 132 * 3; it += gridDim.x) {
        int fr = lane & 15, g = lane >> 4;
        asm volatile("" : "+v"(fr), "+v"(g));
        const int tt = it / 3, hg = it % 3;
        const int m = tt * 128 + wave * 16 + fr;
        int b, tpos, len, s;
        if (m < ML) { b = m >> 13; tpos = m & 8191; len = SEQ; s = CTXL + tpos; } else { b = (m - ML) >> 8; tpos = (m - ML) & 255; len = CTXL; s = tpos; }
        const bool hp = tpos > 0, hn = tpos < len - 1;
        const long offm = hp ? -(long)INCP : 0, offp = hn ? (long)INCP : 0; const float fm = hp ? 1.f : 0.f, fn = hn ? 1.f : 0.f;
        const bf16* zr = Z + (size_t)m * INCP + ZB0;
        bf16x8 xf[12];
#pragma unroll
        for (int ks = 0; ks < 12; ++ks) {
            const int col = 2304 + 32 * ks + 8 * g;
            const u32x4 c0 = *(const u32x4*)(zr + col), cm = *(const u32x4*)(zr + offm + col), cp = *(const u32x4*)(zr + offp + col);
            float val[8];
#pragma unroll
            for (int q = 0; q < 2; ++q) { const f32x4 t0 = *(const f32x4*)(shift + col + 4 * q) * fm, t1 = *(const f32x4*)(shift + BCOLS + col + 4 * q), t2 = *(const f32x4*)(shift + 2 * BCOLS + col + 4 * q) * fn;
                const unsigned m0 = q ? cm.z : cm.x, m1 = q ? cm.w : cm.y, z0 = q ? c0.z : c0.x, z1 = q ? c0.w : c0.y, p0 = q ? cp.z : cp.x, p1 = q ? cp.w : cp.y;
                val[4 * q + 0] = t0.x * bflo(m0) + t1.x * bflo(z0) + t2.x * bflo(p0);
                val[4 * q + 1] = t0.y * bfhi(m0) + t1.y * bfhi(z0) + t2.y * bfhi(p0);
                val[4 * q + 2] = t0.z * bflo(m1) + t1.z * bflo(z1) + t2.z * bflo(p1);
                val[4 * q + 3] = t0.w * bfhi(m1) + t1.w * bfhi(z1) + t2.w * bfhi(p1); }
#pragma unroll
            for (int e = 0; e < 8; ++e) { if (ks < 4) val[e] = tanh_f(val[e]); else if (ks >= 8) val[e] = sigmoid_f(val[e]); }
            u32x4 pk; pk.x = pk2(val[0], val[1]); pk.y = pk2(val[2], val[3]); pk.z = pk2(val[4], val[5]); pk.w = pk2(val[6], val[7]);
            xf[ks] = __builtin_bit_cast(bf16x8, pk);
            if (ks & 1) asm volatile("" ::: "memory");
        }
#pragma unroll 1
        for (int hh = 0; hh < 4; ++hh) {
            const int h = hg * 4 + hh;
            asm volatile("" : "+v"(fr), "+v"(g));
            __syncthreads();
            {
#pragma unroll 2
                for (int i = 0; i < 6; ++i) { const int cid = tid + 512 * i, tok = cid / 24, ch = cid % 24, wh = ch >> 3, col = wh * BW + h * 64 + (ch & 7) * 8;
                    const int mm = tt * 128 + tok; int tp, ln; if (mm < ML) { tp = mm & 8191; ln = SEQ; } else { tp = (mm - ML) & 255; ln = CTXL; }
                    const bool hp_ = tp > 0, hn_ = tp < ln - 1; const float fm_ = hp_ ? 1.f : 0.f, fn_ = hn_ ? 1.f : 0.f;
                    const bf16* zz = Z + (size_t)mm * INCP + ZB0 + col;
                    const u32x4 c0 = *(const u32x4*)zz, cm = *(const u32x4*)(zz - (hp_ ? INCP : 0)), cp = *(const u32x4*)(zz + (hn_ ? INCP : 0));
                    float val[8];
#pragma unroll
                    for (int qq = 0; qq < 2; ++qq) { const f32x4 t0 = *(const f32x4*)(shift + col + 4 * qq) * fm_, t1 = *(const f32x4*)(shift + BCOLS + col + 4 * qq), t2 = *(const f32x4*)(shift + 2 * BCOLS + col + 4 * qq) * fn_;
                        const unsigned m0 = qq ? cm.z : cm.x, m1 = qq ? cm.w : cm.y, z0 = qq ? c0.z : c0.x, z1 = qq ? c0.w : c0.y, p0 = qq ? cp.z : cp.x, p1 = qq ? cp.w : cp.y;
                        val[4 * qq + 0] = t0.x * bflo(m0) + t1.x * bflo(z0) + t2.x * bflo(p0);
                        val[4 * qq + 1] = t0.y * bfhi(m0) + t1.y * bfhi(z0) + t2.y * bfhi(p0);
                        val[4 * qq + 2] = t0.z * bflo(m1) + t1.z * bflo(z1) + t2.z * bflo(p1);
                        val[4 * qq + 3] = t0.w * bfhi(m1) + t1.w * bfhi(z1) + t2.w * bfhi(p1); }
                    u32x4 pk; pk.x = pk2(val[0], val[1]); pk.y = pk2(val[2], val[3]); pk.z = pk2(val[4], val[5]); pk.w = pk2(val[6], val[7]);
                    *(LAS u32x4*)(lds + tok * 400 + ch * 16) = pk; }
#pragma unroll
                for (int i = 0; i < 6; ++i) { const int cid = tid + 512 * i;
                    if (i < 4) { const int cc = cid & 1023, dd = cc >> 9, n = (cc >> 3) & 63, c8 = cc & 7; const bf16* src = ((i < 2) ? w2T : a2T) + ((size_t)(dd * BW + h * 64 + n) * 64 + c8 * 8);
                        *(LAS u32x4*)(lds + 51200 + ((i < 2) ? 0 : 18432) + (dd * 64 + n) * 144 + c8 * 16) = *(const u32x4*)src; }
                    else { const int cc = cid - 2048, n = cc >> 4, c8 = cc & 15; *(LAS u32x4*)(lds + 51200 + 36864 + n * 272 + c8 * 16) = *(const u32x4*)(g2T + ((size_t)(h * 64 + n) * 128 + c8 * 8)); } }
            }
            __syncthreads();
            const LAS unsigned char* rkv = lds + (wave * 16 + fr) * 400 + 8 * g;
            f32x4 kc[4]; float ss = 0.f;
#pragma unroll
            for (int nb = 0; nb < 4; ++nb) {
                const int c = h * 64 + nb * 16 + 4 * g;
                kc[nb] = bf4(*(const LAS u32x2*)(rkv + 128 + nb * 32));
                const f32x4 t = kc[nb] * *(const f32x4*)(kkp + c);
                ss += (t.x * t.x + t.y * t.y) + (t.z * t.z + t.w * t.w);
            }
            ss += __shfl_xor(ss, 16); ss += __shfl_xor(ss, 32);
            const float inv = rsqrtf(fmaxf(ss, 1e-12f));
            bf16* sp = SOP + ((size_t)((b * NH + h) * SL + s)) * 576 + 4 * g;
            float bon = 0.f;
#pragma unroll
            for (int nb = 0; nb < 4; ++nb) {
                const int n = h * 64 + nb * 16 + fr;
                f32x4 accw[2], acca[2], accg = (f32x4){0.f, 0.f, 0.f, 0.f};
#pragma unroll
                for (int d = 0; d < 2; ++d) { accw[d] = (f32x4){0.f, 0.f, 0.f, 0.f}; acca[d] = (f32x4){0.f, 0.f, 0.f, 0.f};
#pragma unroll
                    for (int ksl = 0; ksl < 2; ++ksl) {
                        const bf16x8 wf = *(const LAS bf16x8*)(lds + 51200 + (d * 64 + nb * 16 + fr) * 144 + (32 * ksl + 8 * g) * 2);
                        const bf16x8 af = *(const LAS bf16x8*)(lds + 51200 + 18432 + (d * 64 + nb * 16 + fr) * 144 + (32 * ksl + 8 * g) * 2);
                        accw[d] = MFMA16(wf, xf[2 * d + ksl], accw[d]);
                        acca[d] = MFMA16(af, xf[4 + 2 * d + ksl], acca[d]); } }
#pragma unroll
                for (int ksl = 0; ksl < 4; ++ksl) { const bf16x8 gf = *(const LAS bf16x8*)(lds + 51200 + 36864 + (nb * 16 + fr) * 272 + (32 * ksl + 8 * g) * 2); accg = MFMA16(gf, xf[8 + ksl], accg); }
                const int c = h * 64 + nb * 16 + 4 * g;
                const f32x4 rc = bf4(*(const LAS u32x2*)(rkv + nb * 32)), vc = bf4(*(const LAS u32x2*)(rkv + 256 + nb * 32));
                const f32x4 w00 = *(const f32x4*)(w0 + c), w01 = *(const f32x4*)(w0 + BW + c), a00 = *(const f32x4*)(a0 + c), a01 = *(const f32x4*)(a0 + BW + c);
                const f32x4 kk4 = *(const f32x4*)(kkp + c), ka4 = *(const f32x4*)(kap + c), rk4 = *(const f32x4*)(rkp + c);
                float o[9][4];
#pragma unroll
                for (int e = 0; e < 4; ++e) {
                    const float ad0 = sigmoid_f(a00[e] + acca[0][e]), ad1 = sigmoid_f(a01[e] + acca[1][e]);
                    const float lw0 = -0.60653066f * sigmoid_f(w00[e] + accw[0][e]), lw1 = -0.60653066f * sigmoid_f(w01[e] + accw[1][e]);
                    const float k = kc[nb][e], kk = k * kk4[e] * inv;
                    const float kd0 = k * (1.f + (ad0 - 1.f) * ka4[e]), kd1 = k * (1.f + (ad1 - 1.f) * ka4[e]);
                    bon += rc[e] * (kd0 + kd1) * rk4[e];
                    o[0][e] = rc[e]; o[1][e] = vc[e]; o[2][e] = -kk; o[3][e] = lw0; o[4][e] = kd0; o[5][e] = kk * ad0; o[6][e] = lw1; o[7][e] = kd1; o[8][e] = kk * ad1;
                }
#pragma unroll
                for (int vv = 0; vv < 9; ++vv) { u32x2 w; w.x = pk2(o[vv][0], o[vv][1]); w.y = pk2(o[vv][2], o[vv][3]); *(u32x2*)(sp + vv * 64 + nb * 16) = w; }
                { u32x2 w; w.x = pk2(accg[0], accg[1]); w.y = pk2(accg[2], accg[3]); *(u32x2*)(G + (size_t)m * BW + c) = w; }
            }
            bon += __shfl_xor(bon, 16); bon += __shfl_xor(bon, 32);
#pragma unroll
            for (int nb = 0; nb < 4; ++nb) { const int c = h * 64 + nb * 16 + 4 * g;
                const f32x4 t = bf4(*(const LAS u32x2*)(rkv + 256 + nb * 32)) * bon;
                u32x2 w; w.x = pk2(t.x, t.y); w.y = pk2(t.z, t.w); *(u32x2*)(BV + (size_t)m * BW + c) = w; }
            asm volatile("" ::: "memory");
        }
    }
}

#ifndef SCAN_NCW
#define SCAN_NCW 4
#endif
constexpr int NCW = SCAN_NCW, RPB = 4 * NCW, BPH = 64 / RPB, SCAN_BLOCKS = 48 * BPH, TT = 32, NTILE = SL / TT;
struct StepOps { f32x4 r, a, w, k, b; float v; };
typedef float f32x2 __attribute__((ext_vector_type(2)));
template <int DIR> __device__ __forceinline__ void scan_tile(const LAS float* opq, const LAS float* opv, LAS float* ybq, f32x2& Sx, f32x2& Sy) {
#define TR(i) (DIR ? (TT - 1 - (i)) : (i))
#define SCAN_LOAD(o, i) do { const LAS float* bp = opq + TR(i) * 384; \
        o.r = *(const LAS f32x4*)(bp); o.a = *(const LAS f32x4*)(bp + 128); o.w = *(const LAS f32x4*)(bp + 192); o.k = *(const LAS f32x4*)(bp + 256); o.b = *(const LAS f32x4*)(bp + 320); \
        o.v = opv[TR(i) * 384]; asm volatile("" ::: "memory"); } while (0)
#define SCAN_STEP(o, i) do { \
        f32x2 t_ = Sx * o.a.lo; t_ = Sy * o.a.hi + t_; float sa = t_.x + t_.y; sa = allreduce16(sa); \
        const f32x2 kx_ = o.k.lo * o.v, ky_ = o.k.hi * o.v; \
        Sx = Sx * o.w.lo + (o.b.lo * sa + kx_); Sy = Sy * o.w.hi + (o.b.hi * sa + ky_); \
        f32x2 u_ = Sx * o.r.lo; u_ = Sy * o.r.hi + u_; float yv_ = u_.x + u_.y; yv_ += dpp_mov<0x128>(yv_); ybq[TR(i) * RPB * 8] = yv_; asm volatile("" ::: "memory"); } while (0)
    StepOps X0, X1, X2, X3;
    SCAN_LOAD(X0, 0); SCAN_LOAD(X1, 1);
#pragma unroll
    for (int i = 0; i < TT; i += 4) {
        SCAN_LOAD(X2, i + 2); SCAN_STEP(X0, i);
        SCAN_LOAD(X3, i + 3); SCAN_STEP(X1, i + 1);
        if (i + 4 < TT) SCAN_LOAD(X0, i + 4);
        SCAN_STEP(X2, i + 2);
        if (i + 4 < TT) SCAN_LOAD(X1, i + 5);
        SCAN_STEP(X3, i + 3);
    }
#undef TR
#undef SCAN_LOAD
#undef SCAN_STEP
}
__device__ __forceinline__ void scan_block(int pair, int part, const bf16* SOP, bf16* Y, LAS unsigned char* lds, int tid, int wave, int lane, int pf = 3) {
    static_assert(NCW == 4, "waves 0-3 compute, waves 4-7 stage operands and write y out");
    const int d = pair / 24, b = (pair % 24) / 12, h = pair % 12;
    LAS float* op0 = (LAS float*)lds;
    LAS float* op1 = (LAS float*)(lds + 49152);
    LAS float* yb0 = (LAS float*)(lds + 98304);
    LAS float* yb1 = (LAS float*)(lds + 98304 + 32 * RPB * 8 * 4);
    const int q = lane & 15, rl = (wave & 3) * 4 + (lane >> 4);
    const bf16* sbase = SOP + (size_t)((b * NH + h) * SL) * 576;
    const int ht = tid - 256, part8 = ht & 7, stok = ht >> 3;
    u32x4 sa_[6], sb_[6];
#define SCAN_S0(j) (d == 0 ? TT * (j) : ((j) < 8 ? CTXL - TT * ((j) + 1) : SL - TT * ((j) - 8 + 1)))
#define SCAN_ISSUE(dst, j) do { const bf16* sp_ = sbase + ((size_t)SCAN_S0(j) + stok) * 576 + part8 * 8; \
        _Pragma("unroll") for (int i = 0; i < 6; ++i) dst[i] = *(const u32x4*)(sp_ + ((i < 3) ? i : 3 + 3 * d + (i - 3)) * 64); } while (0)
#define SCAN_STAGE(src, opb) do { _Pragma("unroll") for (int i = 0; i < 6; ++i) { \
            f32x4 lo = {bflo(src[i].x), bfhi(src[i].x), bflo(src[i].y), bfhi(src[i].y)}, hi = {bflo(src[i].z), bfhi(src[i].z), bflo(src[i].w), bfhi(src[i].w)}; \
            if (i == 3) { lo.x = __expf(lo.x); lo.y = __expf(lo.y); lo.z = __expf(lo.z); lo.w = __expf(lo.w); hi.x = __expf(hi.x); hi.y = __expf(hi.y); hi.z = __expf(hi.z); hi.w = __expf(hi.w); } \
            LAS float* dp = opb + (stok * 6 + i) * 64 + part8 * 8; *(LAS f32x4*)dp = lo; *(LAS f32x4*)(dp + 4) = hi; } } while (0)
#define SCAN_BAR() do { asm volatile("s_waitcnt lgkmcnt(0)" ::: "memory"); __builtin_amdgcn_s_barrier(); asm volatile("" ::: "memory"); } while (0)
#define SCAN_YOUT(ybuf, j) do { const int s0_ = SCAN_S0(j); _Pragma("unroll") for (int i = 0; i < RPB / 8; ++i) { const int idx = ht + 256 * i, tok = idx / RPB, r = idx % RPB; const LAS f32x4* yp = (const LAS f32x4*)(ybuf + idx * 8); \
            const f32x4 t = yp[0] + yp[1]; \
            Y[((size_t)((d * 2 + b) * SL + s0_ + tok)) * BW + h * 64 + part * RPB + r] = (bf16)f2bf((t.x + t.y) + (t.z + t.w)); } } while (0)
#define SCAN_TILE(nxt, j, opc, opn, ybc, ybp) do { \
        if (wave < 4) { if (!(pf & 4)) { \
            if (d == 0) scan_tile<0>(opc + 4 * q, opc + 64 + part * RPB + rl, ybc + rl * 8 + (q & 7), Sx, Sy); \
            else        scan_tile<1>(opc + 4 * q, opc + 64 + part * RPB + rl, ybc + rl * 8 + (q & 7), Sx, Sy); } \
        } else { \
            if ((j) + 1 < NTILE) SCAN_STAGE(nxt, opn); \
            if ((j) + 3 < NTILE) SCAN_ISSUE(nxt, (j) + 3); \
            if ((j) > 0) SCAN_YOUT(ybp, (j) - 1); } \
        SCAN_BAR(); } while (0)
    f32x2 Sx = {0.f, 0.f}, Sy = {0.f, 0.f};
    if (wave < 4) __builtin_amdgcn_s_setprio(3);
    if (wave >= 4) { SCAN_ISSUE(sa_, 0); SCAN_ISSUE(sb_, 1); SCAN_STAGE(sa_, op0); SCAN_ISSUE(sa_, 2); }
    SCAN_BAR();
#pragma unroll 1
    for (int j = 0; j < NTILE; j += 2) { SCAN_TILE(sb_, j, op0, op1, yb0, yb1); SCAN_TILE(sa_, j + 1, op1, op0, yb1, yb0); }
    __builtin_amdgcn_s_setprio(0);
    if (wave >= 4) SCAN_YOUT(yb1, NTILE - 1);
    __syncthreads();
#undef SCAN_TILE
#undef SCAN_YOUT
#undef SCAN_BAR
#undef SCAN_STAGE
#undef SCAN_S0
#undef SCAN_ISSUE
}

constexpr int KSTR = 72;
__device__ __forceinline__ void na_item(int item, const bf16* Z, const float* rpb, bf16* CC, LAS unsigned char* lds, int tid, int wave, int lane) {
    LAS bf16* Ks = (LAS bf16*)lds;
    LAS bf16* Vt = (LAS bf16*)(lds + 9216);
    LAS float* rp = (LAS float*)(lds + 18432);
    const int fr = lane & 15, g = lane >> 4;
    int b, h, is_ctx, qrow, ustart = 0, nloc = 0; size_t mq;
    if (item < 1536) { is_ctx = 0; b = item / 768; const int r = item % 768; h = r / 64; const int rpi = r % 64; const int ri0 = 2 * rpi;
        qrow = ri0 + (wave >> 2); ustart = min(max(ri0 - 4, 0), 120); nloc = min(max(ri0 + 1 - 4, 0), 120) + 8 - ustart;
        mq = (size_t)b * SEQ + qrow * 64 + (wave & 3) * 16 + fr; }
    else { is_ctx = 1; const int r = item - 1536; b = r / 24; h = (r % 24) >> 1; const int p = r & 1; qrow = 0;
        mq = (size_t)ML + b * CTXL + (2 * p + (wave >> 2)) * 64 + (wave & 3) * 16 + fr; }
    const int ci = (wave & 3) * 16 + fr;
    const int wstart = min(max(qrow - 4, 0), 120);
    const int cs = min(max(ci - 8, 0), 48);
    __syncthreads();
    if (!is_ctx) for (int i = tid; i < 465; i += NTHR) rp[i] = rpb[h * 465 + i];
    bf16x8 qf[2];
#pragma unroll
    for (int ks = 0; ks < 2; ++ks) qf[ks] = *(const bf16x8*)(Z + mq * INCP + ZC0 + h * 64 + 32 * ks + 8 * g);
    const int key = tid >> 3, ch = tid & 7;
    auto krow = [&](int t) -> size_t { return t < 9 ? (size_t)b * SEQ + (ustart + t) * 64 + key : (size_t)ML + b * CTXL + (t - 9) * 64 + key; };
    const int ntl = nloc + 4;
#define NA_TID(p) ((p) < nloc ? (p) : 9 + (p) - nloc)
#define NA_LOAD(kd, vd, p) do { const bf16* zp_ = Z + krow(NA_TID(p)) * INCP + ZC0 + h * 64 + ch * 8; kd = *(const u32x4*)(zp_ + 768); vd = *(const u32x4*)(zp_ + 1536); } while (0)
    u32x4 k0 = {0u, 0u, 0u, 0u}, v0 = k0, k1 = k0, v1 = k0, k2 = k0, v2 = k0;
    NA_LOAD(k0, v0, 0); NA_LOAD(k1, v1, 1); NA_LOAD(k2, v2, 2);
    int doff[4][4]; float madd[4][4];
#pragma unroll
    for (int nb = 0; nb < 4; ++nb)
#pragma unroll
        for (int e = 0; e < 4; ++e) { const int ck = nb * 16 + 4 * g + e; doff[nb][e] = min(max(ck - ci + 15, 0), 30); madd[nb][e] = ((ck >= cs) && (ck < cs + 16)) ? 0.f : -1e30f; }
    const int qblk = wave & 3, nlo = (qblk >= 2) ? qblk - 1 : 0, nhi = (qblk <= 1) ? qblk + 1 : 3;
    float mrun = -1e30f, lrun = 0.f;
    f32x4 oacc[4];
#pragma unroll
    for (int nb = 0; nb < 4; ++nb) oacc[nb] = (f32x4){0.f, 0.f, 0.f, 0.f};
    for (int p = 0; p < ntl; ++p) {
        const int t = NA_TID(p);
        __syncthreads();
        *(LAS u32x4*)(Ks + key * KSTR + ch * 8) = k0;
        { const unsigned w[4] = {v0.x, v0.y, v0.z, v0.w};
#pragma unroll
          for (int e = 0; e < 4; ++e) { Vt[(ch * 8 + 2 * e) * KSTR + key] = (bf16)(w[e] & 0xffffu); Vt[(ch * 8 + 2 * e + 1) * KSTR + key] = (bf16)(w[e] >> 16); } }
        __syncthreads();
        k0 = k1; v0 = v1; k1 = k2; v1 = v2;
        if (p + 3 < ntl) NA_LOAD(k2, v2, p + 3);
        const int br = ustart + t;
        const bool active = (t >= 9) || (br >= wstart && br < wstart + 8);
        if (active) {
            const bool loc = t < 9;
            f32x4 sc[4];
            float mt = -1e30f;
            const int dr31 = (br - qrow + 7) * 31;
#pragma unroll
            for (int nb = 0; nb < 4; ++nb) {
                const bool nbon = !loc || (nb >= nlo && nb <= nhi);
                sc[nb] = (f32x4){0.f, 0.f, 0.f, 0.f};
                if (nbon) {
#pragma unroll
                    for (int ks = 0; ks < 2; ++ks) { const bf16x8 kf = *(const LAS bf16x8*)(Ks + (nb * 16 + fr) * KSTR + 32 * ks + 8 * g); sc[nb] = MFMA16(kf, qf[ks], sc[nb]); }
                    if (loc) {
#pragma unroll
                        for (int e = 0; e < 4; ++e) { const float v = (sc[nb][e] * 0.125f + rp[dr31 + doff[nb][e]]) + madd[nb][e]; sc[nb][e] = v; mt = fmaxf(mt, v); }
                    } else {
#pragma unroll
                        for (int e = 0; e < 4; ++e) { const float v = sc[nb][e] * 0.125f; sc[nb][e] = v; mt = fmaxf(mt, v); }
                    }
                }
            }
            mt = fmaxf(mt, __shfl_xor(mt, 16)); mt = fmaxf(mt, __shfl_xor(mt, 32));
            const float mnew = fmaxf(mrun, mt), alpha = __expf(mrun - mnew); mrun = mnew;
            float ps = 0.f;
#pragma unroll
            for (int nb = 0; nb < 4; ++nb) {
                const bool nbon = !loc || (nb >= nlo && nb <= nhi);
                if (nbon) {
#pragma unroll
                    for (int e = 0; e < 4; ++e) { const float pp = __expf(sc[nb][e] - mnew); sc[nb][e] = pp; ps += pp; }
                } else sc[nb] = (f32x4){0.f, 0.f, 0.f, 0.f};
            }
            lrun = lrun * alpha + ps;
            bf16x8 pf[2];
#pragma unroll
            for (int ks = 0; ks < 2; ++ks) { u32x4 w; w.x = pk2(sc[2 * ks][0], sc[2 * ks][1]); w.y = pk2(sc[2 * ks][2], sc[2 * ks][3]); w.z = pk2(sc[2 * ks + 1][0], sc[2 * ks + 1][1]); w.w = pk2(sc[2 * ks + 1][2], sc[2 * ks + 1][3]);
                pf[ks] = __builtin_bit_cast(bf16x8, w); }
#pragma unroll
            for (int nb = 0; nb < 4; ++nb) oacc[nb] = oacc[nb] * alpha;
#pragma unroll
            for (int ks = 0; ks < 2; ++ks) {
                const bool kson = !loc || (2 * ks + 1 >= nlo && 2 * ks <= nhi);
                if (kson) {
#pragma unroll
                    for (int nb = 0; nb < 4; ++nb) { const LAS bf16* vp = Vt + (nb * 16 + fr) * KSTR + 32 * ks + 4 * g;
                        const u32x2 lo = *(const LAS u32x2*)vp, hi = *(const LAS u32x2*)(vp + 16);
                        u32x4 w; w.x = lo.x; w.y = lo.y; w.z = hi.x; w.w = hi.y;
                        oacc[nb] = MFMA16(__builtin_bit_cast(bf16x8, w), pf[ks], oacc[nb]); }
                }
            }
        }
    }
#undef NA_TID
#undef NA_LOAD
    lrun += __shfl_xor(lrun, 16); lrun += __shfl_xor(lrun, 32);
    const float il = 1.f / lrun;
    bf16* op = CC + mq * D + 1280 + h * 64 + 4 * g;
#pragma unroll
    for (int nb = 0; nb < 4; ++nb) { u32x2 w; w.x = pk2(oacc[nb][0] * il, oacc[nb][1] * il); w.y = pk2(oacc[nb][2] * il, oacc[nb][3] * il); *(u32x2*)(op + nb * 16) = w; }
}

constexpr int VSTR = 136;
__device__ __forceinline__ void gmlp_item(int item, const bf16* Z, const bf16* gmws, const float* gmbs, bf16* CC, LAS unsigned char* lds, int tid, int wave, int lane) {
    LAS bf16* vt = (LAS bf16*)lds;
    const int cidx = item >> 3, gi = item & 7, fr = lane & 15, g = lane >> 4;
    __syncthreads();
    { const int j = tid >> 2, part = tid & 3; const bf16* zp = Z + (size_t)(cidx * 128 + j) * INCP + 512 + gi * 64 + 16 * part;
      const u32x4 a = *(const u32x4*)zp, bq = *(const u32x4*)(zp + 8);
      float x[16]; const unsigned w[8] = {a.x, a.y, a.z, a.w, bq.x, bq.y, bq.z, bq.w};
      float s = 0.f;
#pragma unroll
      for (int e = 0; e < 8; ++e) { x[2 * e] = gelu_f(bflo(w[e])); x[2 * e + 1] = gelu_f(bfhi(w[e])); s += x[2 * e] + x[2 * e + 1]; }
      s += __shfl_xor(s, 1); s += __shfl_xor(s, 2); const float mu = s * (1.f / 64.f); float s2 = 0.f;
#pragma unroll
      for (int e = 0; e < 16; ++e) { x[e] -= mu; s2 += x[e] * x[e]; }
      s2 += __shfl_xor(s2, 1); s2 += __shfl_xor(s2, 2); const float rstd = rsqrtf(s2 * (1.f / 64.f) + LN_EPS);
#pragma unroll
      for (int e = 0; e < 16; ++e) vt[(16 * part + e) * VSTR + j] = (bf16)f2bf(x[e] * rstd); }
    __syncthreads();
    f32x4 acc[4];
#pragma unroll
    for (int nb = 0; nb < 4; ++nb) acc[nb] = (f32x4){0.f, 0.f, 0.f, 0.f};
    const int i = wave * 16 + fr;
#pragma unroll
    for (int ks = 0; ks < 4; ++ks) { const bf16x8 wf = *(const bf16x8*)(gmws + (size_t)(gi * 128 + i) * 128 + 32 * ks + 8 * g);
#pragma unroll
        for (int nb = 0; nb < 4; ++nb) { const bf16x8 vf = *(const LAS bf16x8*)(vt + (nb * 16 + fr) * VSTR + 32 * ks + 8 * g); acc[nb] = MFMA16(vf, wf, acc[nb]); } }
    const float bs = gmbs[gi * 128 + i];
    const size_t m = (size_t)cidx * 128 + i;
#pragma unroll
    for (int nb = 0; nb < 4; ++nb) { const int c = nb * 16 + 4 * g; const f32x4 u = bf4(*(const u32x2*)(Z + m * INCP + gi * 64 + c));
        u32x2 w; w.x = pk2(gelu_f(u.x) * (acc[nb][0] + bs), gelu_f(u.y) * (acc[nb][1] + bs)); w.y = pk2(gelu_f(u.z) * (acc[nb][2] + bs), gelu_f(u.w) * (acc[nb][3] + bs));
        *(u32x2*)(CC + m * D + gi * 64 + c) = w; }
}

__device__ __forceinline__ void rwkv_out_phase(int nrows, const bf16* Y, const bf16* G, const bf16* BV, const float* gng, const float* gnb, bf16* CC, int tid) {
    const int l16 = tid & 15;
    for (int gi = (blockIdx.x * NTHR + tid) >> 4; gi < nrows * NH; gi += (gridDim.x * NTHR) >> 4) {
        const int m = gi / NH, h = gi % NH; int b, s;
        if (m < ML) { b = m >> 13; s = CTXL + (m & 8191); } else { b = (m - ML) >> 8; s = (m - ML) & 255; }
        const int c = h * 64 + 4 * l16;
        const f32x4 y0 = bf4(*(const u32x2*)(Y + ((size_t)(b * SL + s)) * BW + c)), y1 = bf4(*(const u32x2*)(Y + ((size_t)((2 + b) * SL + s)) * BW + c));
        f32x4 y = y0 + y1;
        float sm = (y.x + y.y) + (y.z + y.w);
#pragma unroll
        for (int o = 1; o < 16; o <<= 1) sm += __shfl_xor(sm, o);
        const float mu = sm * (1.f / 64.f); y = y - mu;
        float s2 = (y.x * y.x + y.y * y.y) + (y.z * y.z + y.w * y.w);
#pragma unroll
        for (int o = 1; o < 16; o <<= 1) s2 += __shfl_xor(s2, o);
        const float rstd = rsqrtf(s2 * (1.f / 64.f) + GN_EPS);
        const f32x4 gg = *(const f32x4*)(gng + c), gb = *(const f32x4*)(gnb + c);
        const f32x4 bv = bf4(*(const u32x2*)(BV + (size_t)m * BW + c)), gt = bf4(*(const u32x2*)(G + (size_t)m * BW + c));
        const f32x4 o = (y * rstd * gg + gb + bv) * gt;
        u32x2 w; w.x = pk2(o.x, o.y); w.y = pk2(o.z, o.w);
        *(u32x2*)(CC + (size_t)m * D + 512 + c) = w;
    }
}

#ifndef PER_PHASE_LAUNCH
#define PER_PHASE_LAUNCH 0
#endif
#ifndef PH_MASK
#define PH_MASK 0x7ff
#endif
#define PHON(k) ((PH_MASK >> (k)) & 1)
#ifndef NA_EARLY
#define NA_EARLY 580
#endif
#ifndef WGM_N2048
#define WGM_N2048 4
#endif
#ifndef WGM_N8192
#define WGM_N8192 4
#endif
constexpr int N_PHASES = 21;
struct Args { In in; float* out; unsigned char* ws; int ph_lo, ph_hi; };
#define XB_TMO      128
#define XB_XCNT(j)  (256  + 64 * (j))
#define XB_XSUB(j)  (1280 + 64 * (j))
#define XB_XGEN(j)  (2304 + 64 * (j))
#define XB_TOP      3328
#define XB_TOPGEN   3392
#define XCD_BAR_WORDS 3456
#define XB_SPIN_CAP (1u << 18)

__device__ __forceinline__ unsigned xb_ld(unsigned* p)              { return __hip_atomic_load(p, __ATOMIC_RELAXED, __HIP_MEMORY_SCOPE_AGENT); }
__device__ __forceinline__ unsigned xb_add(unsigned* p, unsigned v) { return __hip_atomic_fetch_add(p, v, __ATOMIC_RELAXED, __HIP_MEMORY_SCOPE_AGENT); }
__device__ __forceinline__ unsigned xb_xcc_id() { return (unsigned)__builtin_amdgcn_s_getreg((3 << 11) | 20) & 0xFu; }
#define XB_SPIN(cond, bar) do { unsigned _sp = 0; while (cond) { __builtin_amdgcn_s_sleep(1); \
    if ((++_sp & 255u) == 0u) { if (xb_ld(&(bar)[XB_TMO])) break; if (_sp > XB_SPIN_CAP) { atomicAdd(&(bar)[XB_TMO], 1u); break; } } } } while (0)

struct XcdBarrier {
    unsigned* bar; unsigned x;
    volatile LAS unsigned* st;
};

__device__ __forceinline__ XcdBarrier xcd_barrier_post(unsigned* bar, volatile LAS unsigned* st) {
    XcdBarrier b; b.bar = bar; b.x = xb_xcc_id(); b.st = st;
    if (threadIdx.x == 0) (void)xb_add(&bar[XB_XCNT(b.x)], 1u);
    return b;
}
__device__ __forceinline__ void xcd_barrier_complete(unsigned* bar, unsigned x, unsigned& nloc, unsigned& nx) {
    const unsigned G = gridDim.x * gridDim.y * gridDim.z;
    unsigned sum, cnt, mine, sp = 0u;
    for (;;) {
        sum = 0u; cnt = 0u; mine = 0u;
#pragma unroll
        for (unsigned j = 0; j < 16; ++j) { const unsigned c = xb_ld(&bar[XB_XCNT(j)]); sum += c; cnt += (c > 0u) ? 1u : 0u; mine = (j == x) ? c : mine; }
        if (sum == G) break;
        __builtin_amdgcn_s_sleep(1);
        if ((++sp & 255u) == 0u) { if (xb_ld(&bar[XB_TMO])) break; if (sp > XB_SPIN_CAP) { atomicAdd(&bar[XB_TMO], 1u); break; } }
    }
    nloc = mine > 0u ? mine : 1u; nx = cnt > 0u ? cnt : 1u;
}

__device__ __forceinline__ void xcd_barrier(const XcdBarrier& b) {
    asm volatile("s_waitcnt vmcnt(0)" ::: "memory");
    __syncthreads();
    if (threadIdx.x == 0) {
        unsigned* bar = b.bar;
        __builtin_amdgcn_s_waitcnt(0);
        unsigned nloc = b.st[0], nx = b.st[1];
        if (nloc == 0u) { xcd_barrier_complete(bar, b.x, nloc, nx); b.st[0] = nloc; b.st[1] = nx; }
        const unsigned old = xb_add(&bar[XB_XSUB(b.x)], 1u);
        const unsigned gen = old / nloc;
        if (old + 1u == (gen + 1u) * nloc) {
            __builtin_amdgcn_fence(__ATOMIC_RELEASE, "agent");
            asm volatile("s_waitcnt vmcnt(0)" ::: "memory");
            const unsigned og = xb_add(&bar[XB_TOP], 1u);
            const unsigned tg = og / nx;
            if (og + 1u == (tg + 1u) * nx) xb_add(&bar[XB_TOPGEN], 1u);
            else XB_SPIN(xb_ld(&bar[XB_TOPGEN]) == tg, bar);
            __builtin_amdgcn_fence(__ATOMIC_ACQUIRE, "agent");
            xb_add(&bar[XB_XGEN(b.x)], 1u);
            asm volatile("s_waitcnt vmcnt(0)" ::: "memory");
        } else {
            XB_SPIN(xb_ld(&bar[XB_XGEN(b.x)]) == gen, bar);
            __builtin_amdgcn_fence(__ATOMIC_ACQUIRE, "agent");
            asm volatile("s_waitcnt vmcnt(0)" ::: "memory");
        }
    }
    __syncthreads();
}

constexpr size_t WS_BAR = WS_CTL + 320 * 1024;
constexpr int LDS_BARW = LDS_BYTES - 64;

template <int PH> __device__ __forceinline__ void run_phase(const Args& args, LAS unsigned char* lds, int part = 3) {
    const int tid = threadIdx.x, lane = tid & 63, wave = __builtin_amdgcn_readfirstlane(tid >> 6);
    const int gw = blockIdx.x * NWAVES + wave, NGW = gridDim.x * NWAVES;
    const In& in = args.in;
    unsigned char* ws = args.ws;
    float* mod = (float*)(ws + WS_CTL);
    bf16* small = (bf16*)(ws + WS_SMALL);
    float* XC = (float*)(ws + WS_XC); float* XL = args.out;
    bf16* AC = (bf16*)(ws + WS_AC); bf16* Z = (bf16*)(ws + WS_Z);
    if constexpr (PH == 0) {
        if (PHON(10)) { mod_gemv(in, mod, gw, NGW, lane); convert_weights(in, 0, 0, ws, lds, gw, NGW, wave, lane); }
    } else {
        constexpr int l = (PH - 1) / 10, sub = (PH - 1) % 10;
        const float* modl = mod + (size_t)l * 3 * NMOD;
        constexpr int Mrows = (l == 0) ? MT : ML;
        if constexpr (sub == 0) {
            if (l == 0 && PHON(0)) rowwise(gw, NGW, lane, MT, in.p[0], in.p[2], XL, XC, false, in.p[22], in.p[23], true, modl, 0, 1, AC);
        } else if constexpr (sub == 1) { if (PHON(1)) {
            pg8::Gemm g{AC, (bf16*)(ws + WS_WIN), ML, INCP, D}; pg8::StaticOrder S; S.init(ML, INCP, (int)gridDim.x, (int)blockIdx.x);
            EpiStoreBf16<0> E{Z, INCP};
            pg8::gemm_phase<EpiStoreBf16<0>, pg8::StaticOrder, true, true>(lds, g, S, E); }
        } else if constexpr (sub == 2) { if (PHON(2)) {
            rwkv_proj_phase(Z, in.p[9] + (size_t)l * 3 * BCOLS, in.p[10] + (size_t)l * 2 * BW, in.p[12] + (size_t)l * 2 * BW, in.p[15] + (size_t)l * BW, in.p[16] + (size_t)l * BW,
                            in.p[17] + (size_t)l * BW, small + SM_W2T, small + SM_A2T, small + SM_G2T, (bf16*)(ws + WS_SOP), (bf16*)(ws + WS_G), (bf16*)(ws + WS_BV), lds, tid, wave, lane);
            if ((int)blockIdx.x >= 140) for (int it = (int)blockIdx.x - 140; it < NA_EARLY; it += (int)gridDim.x - 140) na_item(it, Z, in.p[20] + (size_t)l * NH * 465, AC, lds, tid, wave, lane); }
        } else if constexpr (sub == 3) { if (PHON(3)) {
            if ((int)blockIdx.x < SCAN_BLOCKS) { if (part & 1) {
                const int blk = blockIdx.x, x = blk & 7, slot = blk >> 3, pair = x + 8 * (slot / BPH), quarter = slot % BPH;
                scan_block(pair, quarter, (const bf16*)(ws + WS_SOP), (bf16*)(ws + WS_Y), lds, tid, wave, lane, part); }
            } else if (part & 2) {
                constexpr int nNA = (l == 0) ? 1584 : 1536, nG = (l == 0) ? 1056 : 1024;
                for (int it = NA_EARLY + (int)blockIdx.x - SCAN_BLOCKS; it < nNA + nG; it += (int)gridDim.x - SCAN_BLOCKS) {
                    if (it < nNA) na_item(it, Z, in.p[20] + (size_t)l * NH * 465, AC, lds, tid, wave, lane);
                    else gmlp_item(it - nNA, Z, small + SM_GMWS, in.p[8] + (size_t)l * 1024, AC, lds, tid, wave, lane);
                }
                __syncthreads();
                convert_weights(in, l, 1, ws, lds, ((int)blockIdx.x - SCAN_BLOCKS) * NWAVES + wave, ((int)gridDim.x - SCAN_BLOCKS) * NWAVES, wave, lane);
            } }
        } else if constexpr (sub == 4) { if (PHON(4)) {
            rwkv_out_phase(Mrows, (const bf16*)(ws + WS_Y), (const bf16*)(ws + WS_G), (const bf16*)(ws + WS_BV), in.p[18] + (size_t)l * BW, in.p[19] + (size_t)l * BW, AC, tid); }
        } else if constexpr (sub == 5) { if (PHON(5)) {
            pg8::Gemm g{AC, (bf16*)(ws + WS_WOUT), ML, D, D}; pg8::StaticOrder S; S.init(ML, D, (int)gridDim.x, (int)blockIdx.x, WGM_N2048);
            EpiRes E{(l == 0) ? in.p[0] : (const float*)XL, (l == 0) ? in.p[2] : (const float*)XC, XL, XC, modl + 2 * D};
            pg8::gemm_phase<EpiRes, pg8::StaticOrder, true, true>(lds, g, S, E); }
        } else if constexpr (sub == 6) { if (PHON(6)) {
            rowwise(gw, NGW, lane, Mrows, XL, (l == 0) ? in.p[2] : (const float*)XC, XL, XC, true, in.p[22] + (size_t)l * D, in.p[23] + (size_t)l * D, true, modl, 3, 4, AC, (const float*)(ws + WS_SLAB), (l == 0) ? 8 : 0); }
        } else if constexpr (sub == 7) { if (PHON(7)) {
            pg8::Gemm g{AC, (bf16*)(ws + WS_WUP), Mrows, DFF, D}; pg8::StaticOrder S; S.init(Mrows, DFF, (int)gridDim.x, (int)blockIdx.x, WGM_N8192);
            EpiStoreBf16<1> E{(bf16*)(ws + WS_HM), DFF};
            pg8::gemm_phase<EpiStoreBf16<1>, pg8::StaticOrder, true, true>(lds, g, S, E); }
        } else if constexpr (sub == 8) { if (PHON(8)) {
            pg8::Gemm g{(bf16*)(ws + WS_HM), (bf16*)(ws + WS_WDN), ML, D, DFF}; pg8::StaticOrder S; S.init(ML, D, (int)gridDim.x, (int)blockIdx.x, WGM_N2048);
            EpiRes E{XL, XC, XL, XC, modl + 5 * D};
            pg8::gemm_phase<EpiRes, pg8::StaticOrder, true, true>(lds, g, S, E); }
        } else { if (PHON(9)) {
            rowwise(gw, NGW, lane, Mrows, XL, XC, XL, XC, true, in.p[26] + (size_t)l * D, in.p[27] + (size_t)l * D, l == 0, modl + 3 * NMOD, 0, 1, AC, (const float*)(ws + WS_SLAB), (l == 0) ? 16 : 0);
            if (l == 0) { __syncthreads(); convert_weights(in, 1, 0, ws, lds, gw, NGW, wave, lane); } }
        }
    }
}
template <int PH> __device__ __forceinline__ void run_ctx(const Args& args, LAS unsigned char* lds) {
    unsigned char* ws = args.ws;
    if constexpr (PH == 6 || PH == 9) {
        const float* modl = (const float*)(ws + WS_CTL);
        const int KS = (PH == 6) ? 256 : 512, LDK = (PH == 6) ? D : DFF, NS = (PH == 6) ? 8 : 16;
        const bf16* A = (PH == 6) ? (const bf16*)(ws + WS_AC) + (size_t)ML * D : (const bf16*)(ws + WS_HM) + (size_t)ML * DFF;
        const bf16* W = (PH == 6) ? (const bf16*)(ws + WS_WOUT) : (const bf16*)(ws + WS_WDN);
        pg8::Gemm g2{A, W, 2 * CTXL, D, KS, LDK}; SplitKOrder S2{2, 8, NS, (int)gridDim.x, (int)blockIdx.x};
        EpiSlabCtx E2{(float*)(ws + WS_SLAB), modl + 2 * NMOD + ((PH == 6) ? 2 : 5) * D, D};
        pg8::gemm_phase<EpiSlabCtx, SplitKOrder, true, true>(lds, g2, S2, E2);
    } else if constexpr (PH == 2 || PH == 12) {
        pg8::Gemm g2{(const bf16*)(ws + WS_AC) + (size_t)ML * D, (const bf16*)(ws + WS_WIN), 2 * CTXL, INCP, 512, D}; SplitKOrder S2{2, 24, 4, (int)gridDim.x, (int)blockIdx.x};
        EpiSlabCtx E2{(float*)(ws + WS_SLAB), nullptr, INCP};
        pg8::gemm_phase<EpiSlabCtx, SplitKOrder, true, true>(lds, g2, S2, E2);
    }
}
__device__ __forceinline__ void hctx_sum(const Args& args) {
    const float* slab = (const float*)(args.ws + WS_SLAB); bf16* H = (bf16*)(args.ws + WS_HM) + (size_t)ML * DFF;
    constexpr int NG = 2 * CTXL * DFF / 4; constexpr size_t SS = (size_t)2 * CTXL * DFF;
    for (int i = blockIdx.x * NTHR + threadIdx.x; i < NG; i += gridDim.x * NTHR) {
        f32x4 v = (*(const f32x4*)(slab + 4 * (size_t)i) + *(const f32x4*)(slab + SS + 4 * (size_t)i)) + (*(const f32x4*)(slab + 2 * SS + 4 * (size_t)i) + *(const f32x4*)(slab + 3 * SS + 4 * (size_t)i));
        v.x = fmaxf(v.x, 0.f); v.y = fmaxf(v.y, 0.f); v.z = fmaxf(v.z, 0.f); v.w = fmaxf(v.w, 0.f); v = v * v;
        u32x2 o; o.x = pk2(v.x, v.y); o.y = pk2(v.z, v.w); *(u32x2*)(H + 4 * (size_t)i) = o; }
}
__device__ __forceinline__ void zctx_sum(const Args& args) {
    const float* slab = (const float*)(args.ws + WS_SLAB); bf16* Z = (bf16*)(args.ws + WS_Z) + (size_t)ML * INCP;
    constexpr int NG = 2 * CTXL * INCP / 4; constexpr size_t SS = (size_t)2 * CTXL * INCP;
    for (int i = blockIdx.x * NTHR + threadIdx.x; i < NG; i += gridDim.x * NTHR) {
        const f32x4 v = (*(const f32x4*)(slab + 4 * (size_t)i) + *(const f32x4*)(slab + SS + 4 * (size_t)i)) + (*(const f32x4*)(slab + 2 * SS + 4 * (size_t)i) + *(const f32x4*)(slab + 3 * SS + 4 * (size_t)i));
        u32x2 o; o.x = pk2(v.x, v.y); o.y = pk2(v.z, v.w); *(u32x2*)(Z + 4 * (size_t)i) = o; }
}
__global__ void __launch_bounds__(NTHR, 2) fwd_megakernel(Args args) {
    extern __shared__ __attribute__((aligned(16))) unsigned char lds_raw[];
    LAS unsigned char* lds = (LAS unsigned char*)lds_raw;
    cg::grid_group grid = cg::this_grid();
    const int lo = args.ph_lo, hi = args.ph_hi;
    if (threadIdx.x < 16) ((LAS unsigned*)(lds + LDS_BARW))[threadIdx.x] = 0u;
    __syncthreads();
    const XcdBarrier xbar = xcd_barrier_post((unsigned*)(args.ws + WS_BAR), (volatile LAS unsigned*)(lds + LDS_BARW));
#define GRID_SYNC(PH) do { if ((PH) == 0) grid.sync(); else xcd_barrier(xbar); } while (0)
#ifndef REP_PART
#define REP_PART 3
#endif
#ifndef REP_MASK
#define REP_MASK 0
#endif
#define REPON(PH) ((PH) > 0 && ((REP_MASK >> (((PH) - 1) % 10)) & 1))
#define DO(PH) if (lo <= (PH) && (PH) < hi) { if (REPON(PH)) { if (REP_PART != 64) run_phase<PH>(args, lds, REP_PART); if ((PH) == 0) grid.sync(); else xcd_barrier(xbar); } run_phase<PH>(args, lds); run_ctx<PH>(args, lds); if ((PH) == 2 || (PH) == 12) { xcd_barrier(xbar); zctx_sum(args); } if ((PH) + 1 < hi) GRID_SYNC(PH); }
    DO(0) DO(1) DO(2) DO(3) DO(4) DO(5) DO(6) DO(7) DO(8) DO(9) DO(10)
    DO(11) DO(12) DO(13) DO(14) DO(15) DO(16) DO(17) DO(18) DO(19) DO(20)
#undef DO
}

extern "C" void kernel_launch(void* const* d_in, const int* in_sizes, int n_in, void* d_out, int out_size, void* d_ws, size_t ws_size, hipStream_t stream) {
    static int grid = 0;
    if (grid == 0) {
        if (n_in != 28 || ws_size < WS_END) { fprintf(stderr, "kernel_launch: unexpected n_in %d / ws_size %zu (need %zu)\n", n_in, ws_size, (size_t)WS_END); grid = -1; return; }
        int dev = 0, cus = 0;
        if (hipGetDevice(&dev) != hipSuccess || hipDeviceGetAttribute(&cus, hipDeviceAttributeMultiprocessorCount, dev) != hipSuccess) { grid = -1; return; }
        if (hipFuncSetAttribute((const void*)fwd_megakernel, hipFuncAttributeMaxDynamicSharedMemorySize, LDS_BYTES) != hipSuccess) { fprintf(stderr, "kernel_launch: hipFuncSetAttribute failed\n"); grid = -1; return; }
        grid = cus;
    }
    if (grid < 0) return;
    (void)hipMemsetAsync((char*)d_ws + WS_CTL, 0, CTL_BYTES, stream);
    Args a{};
    for (int i = 0; i < 28; ++i) a.in.p[i] = (const float*)d_in[i];
    a.out = (float*)d_out; a.ws = (unsigned char*)d_ws;
#if PER_PHASE_LAUNCH
    for (int ph = 0; ph < N_PHASES; ++ph) { a.ph_lo = ph; a.ph_hi = ph + 1; hipLaunchKernelGGL(fwd_megakernel, dim3(grid), dim3(NTHR), LDS_BYTES, stream, a); }
#else
    a.ph_lo = 0; a.ph_hi = N_PHASES;
    void* kargs[] = {&a};
    hipError_t e = hipLaunchCooperativeKernel((const void*)fwd_megakernel, dim3(grid), dim3(NTHR), kargs, LDS_BYTES, stream);
    if (e != hipSuccess) fprintf(stderr, "cooperative launch failed: %s (grid %d)\n", hipGetErrorString(e), grid);
#endif
}
```

```cpp
#include <hip/hip_runtime.h>
#include <hip/hip_cooperative_groups.h>
#include <cstdio>
#include <cstdint>
namespace cg = cooperative_groups;
#define NA_EARLY 464
#define WGM_N2048 2
namespace pg8 {
#define PG8_LAS __attribute__((address_space(3)))
typedef unsigned short bf16_t;
typedef short bf16x8 __attribute__((ext_vector_type(8)));
typedef float f32x4 __attribute__((ext_vector_type(4)));
typedef unsigned u32x4 __attribute__((ext_vector_type(4)));
constexpr int BM = 256, BK = 64, HALF = 128, HTB = HALF * BK * 2  , STAGE_BYTES = 8 * HTB, NXCD = 8, WGM = 8;

__host__ __device__ __forceinline__ int lds_byte(int r, int c) { const int st = (r >> 4) * 2 + (c >> 5), rr = r & 15, cc = c & 31, ob = rr * 64 + cc * 2; return st * 1024 + (ob ^ (((ob >> 9) & 1) << 5)); }
__host__ __device__ __forceinline__ void stage_rc(int b, int& R, int& C) { const int st = b / 1024, sb = b % 1024, swz = sb ^ (((sb >> 9) & 1) << 5); R = (st >> 1) * 16 + swz / 64; C = (st & 1) * 32 + (swz % 64) / 2; }
__host__ __device__ __forceinline__ int perm32(int rho) { const int n = rho >> 4, i = rho & 15; return 8 * (i >> 2) + 4 * n + (i & 3); }

struct Unit { int pm, pn, ks; };
struct Gemm { const bf16_t* A; const bf16_t* Bt; int M, N, K; int ld = 0; };

struct StaticOrder {
    int nM, nN, nwg, G, c, wgm;
    __host__ __device__ void init(int M, int N, int G_, int c_, int wgm_ = WGM) { nM = M / BM; nN = N / BM; nwg = nM * nN; G = G_; c = c_; wgm = wgm_; }
    __host__ __device__ bool next(int i, Unit& u) const {
        const long L = (long)i * G + c; if (L >= nwg) return false;
        int wgid = (int)L; { const int q = nwg / NXCD, r = nwg % NXCD, xcd = wgid % NXCD, off = wgid / NXCD; wgid = (xcd < r ? xcd * (q + 1) : r * (q + 1) + (xcd - r) * q) + off; }
        const int nig = wgm * nN, gid = wgid / nig, fm = gid * wgm, gsz = (nM - fm) < wgm ? (nM - fm) : wgm;
        u.pm = fm + ((wgid % nig) % gsz); u.pn = (wgid % nig) / gsz; u.ks = 0; return true;
    }
    __device__ __forceinline__ void a_ready(const Unit&) const {}
    __device__ __forceinline__ void done(const Unit&) const {}
};

__device__ __forceinline__ unsigned cvt_pk_bf16(float lo, float hi) { unsigned r; asm volatile("v_cvt_pk_bf16_f32 %0, %1, %2" : "=v"(r) : "v"(lo), "v"(hi)); return r; }
typedef float f32x2 __attribute__((ext_vector_type(2)));
__device__ __forceinline__ f32x2 gelu_pk(f32x2 v) {
    const f32x2 av = __builtin_elementwise_abs(v), d = av * 0.2316418882f + 1.0f;
    f32x2 t; t.x = __builtin_amdgcn_rcpf(d.x); t.y = __builtin_amdgcn_rcpf(d.y);
    f32x2 q = t * 0.5307027145f + (-0.7265760135f); q = q * t + 0.7107068705f; q = q * t + (-0.142248368f); q = q * t + 0.127414796f; q = q * t;
    const f32x2 s = (v * v) * (-0.72134752044f);
    f32x2 e; e.x = __builtin_amdgcn_exp2f(s.x); e.y = __builtin_amdgcn_exp2f(s.y);
    const f32x2 m = v * (q * e), r = v - m;
    f32x2 o; o.x = v.x < 0.f ? m.x : r.x; o.y = v.y < 0.f ? m.y : r.y; return o;
}

template <int ACT  > struct EpiBf16 {
    static constexpr bool PERM = true, AFTER_DRAIN = false; static_assert(ACT == 0 || ACT == 1, "EpiBf16: ACT is 0 (none) or 1 (gelu_pk)");
    bf16_t* O; int ldc; const float* bias; int split_cols; size_t split_stride; float scale0;
    __device__ __forceinline__ void operator()(const f32x4 (&acc)[2][2][4][2], const Unit& u, int wr, int wc, int fr, int fq) const {
        const int row0 = u.pm * BM + wr * 64 + fr; int colt = u.pn * BM; bf16_t* base = O;
        float sc = 1.f; if (split_cols) { const int t = colt / split_cols; base += (size_t)t * split_stride; colt -= t * split_cols; if (t == 0) sc = scale0; }
        const int col0 = colt + wc * 32 + 8 * fq, bcol0 = u.pn * BM + wc * 32 + 8 * fq;
        f32x4 bv[2][2];
#pragma unroll
        for (int bj = 0; bj < 2; ++bj)
#pragma unroll
            for (int n = 0; n < 2; ++n) bv[bj][n] = bias ? *(const f32x4*)(bias + bcol0 + bj * HALF + 4 * n) : (f32x4){0.f, 0.f, 0.f, 0.f};
#pragma unroll
        for (int ai = 0; ai < 2; ++ai)
#pragma unroll
            for (int m = 0; m < 4; ++m) { bf16_t* rowp = base + (size_t)(row0 + ai * HALF + m * 16) * ldc + col0;
#pragma unroll
                for (int bj = 0; bj < 2; ++bj) { f32x4 v0 = acc[ai][bj][m][0] + bv[bj][0], v1 = acc[ai][bj][m][1] + bv[bj][1];
                    if (ACT == 1) { f32x2 a = gelu_pk((f32x2){v0[0], v0[1]}), b = gelu_pk((f32x2){v0[2], v0[3]}), c = gelu_pk((f32x2){v1[0], v1[1]}), d = gelu_pk((f32x2){v1[2], v1[3]});
                        v0 = (f32x4){a.x, a.y, b.x, b.y}; v1 = (f32x4){c.x, c.y, d.x, d.y}; }
                    v0 = v0 * sc; v1 = v1 * sc; u32x4 w; w.x = cvt_pk_bf16(v0[0], v0[1]); w.y = cvt_pk_bf16(v0[2], v0[3]); w.z = cvt_pk_bf16(v1[0], v1[1]); w.w = cvt_pk_bf16(v1[2], v1[3]);
                    *(u32x4*)(rowp + bj * HALF) = w; } }
    }
};

template <class Epi, class Sched, bool ALIGN_EPI = false, bool SP2 = false>
__device__ __forceinline__ void gemm_phase(PG8_LAS unsigned char* lds, const Gemm g, const Sched& S, const Epi& E) {
    const int tid = threadIdx.x, wid = __builtin_amdgcn_readfirstlane(tid >> 6), lane = tid & 63, wr = wid >> 2, wc = wid & 3, fr = lane & 15, fq = lane >> 4;
    const int K = g.K, nt = K / BK, LD = g.ld ? g.ld : g.K;
    unsigned voffA[2], voffB[2];
#pragma unroll
    for (int i = 0; i < 2; ++i) { int R, C; stage_rc(tid * 16 + i * 8192, R, C); const int Rb = Epi::PERM ? ((R & ~31) + perm32(R & 31)) : R;
        voffA[i] = (unsigned)(R * LD + C) * 2u; voffB[i] = (unsigned)(Rb * LD + C) * 2u; }
    const size_t kstep = (size_t)(BK * 2);
    const size_t hstep = (size_t)HALF * LD * 2;
    const size_t tstep = 2 * hstep;
    const unsigned ldsw = (unsigned)wid * 1024u;
    const int aoff = lds_byte(wr * 64 + fr, fq * 8), boff = lds_byte(wc * 32 + fr, fq * 8);
#define PG8_SA(b, h) (((b) * 2 + (h)) * HTB)
#define PG8_SB(b, h) ((4 + (b) * 2 + (h)) * HTB)
#define PG8_STAGE(bufoff, gbase, voff) do { _Pragma("unroll") for (int _i = 0; _i < 2; ++_i) \
        __builtin_amdgcn_global_load_lds((const unsigned*)((const char*)(gbase) + (voff)[_i]), (PG8_LAS unsigned*)(lds + (bufoff) + ldsw + _i * 8192), 16, 0, 0); } while (0)
#define PG8_LDA(dst, b, h) do { _Pragma("unroll") for (int m = 0; m < 4; ++m) _Pragma("unroll") for (int k = 0; k < 2; ++k) dst[m][k] = *(const PG8_LAS bf16x8*)(lds + PG8_SA(b, h) + aoff + m * 2048 + k * 1024); } while (0)
#define PG8_LDB(dst, b, h) do { _Pragma("unroll") for (int n = 0; n < 2; ++n) _Pragma("unroll") for (int k = 0; k < 2; ++k) dst[n][k] = *(const PG8_LAS bf16x8*)(lds + PG8_SB(b, h) + boff + n * 2048 + k * 1024); } while (0)
#define PG8_MMA(ai, bj, At, Bt) do { __builtin_amdgcn_s_setprio(1); _Pragma("unroll") for (int m = 0; m < 4; ++m) _Pragma("unroll") for (int n = 0; n < 2; ++n) _Pragma("unroll") for (int k = 0; k < 2; ++k) \
        acc[ai][bj][m][n] = __builtin_amdgcn_mfma_f32_16x16x32_bf16(Bt[n][k], At[m][k], acc[ai][bj][m][n], 0, 0, 0); __builtin_amdgcn_s_setprio(0); } while (0)
#define PG8_WAIT_V(n) asm volatile("s_waitcnt vmcnt(" #n ")" ::: "memory")
#define PG8_WAIT_L(n) asm volatile("s_waitcnt lgkmcnt(" #n ")" ::: "memory")
#define PG8_BAR __builtin_amdgcn_s_barrier()
#define PG8_SCHED __builtin_amdgcn_sched_barrier(0)
    Unit cur, nxt; int ui = 0;
    if (!S.next(0, cur)) return;
    f32x4 acc[2][2][4][2];
#pragma unroll
    for (int a = 0; a < 2; ++a)
#pragma unroll
        for (int b = 0; b < 2; ++b)
#pragma unroll
            for (int m = 0; m < 4; ++m)
#pragma unroll
                for (int n = 0; n < 2; ++n) acc[a][b][m][n] = (f32x4){0.f, 0.f, 0.f, 0.f};
    bf16x8 At[4][2], B0[2][2], B1[2][2];
    const char* cA = (const char*)g.A + (size_t)cur.pm * tstep + (size_t)cur.ks * K * 2; const char* cB = (const char*)g.Bt + (size_t)cur.pn * tstep + (size_t)cur.ks * K * 2;
    S.a_ready(cur);
    if constexpr (SP2) {
        PG8_STAGE(PG8_SB(0, 0), cB, voffB); PG8_STAGE(PG8_SB(0, 1), cB + hstep, voffB); PG8_STAGE(PG8_SA(0, 0), cA, voffA); PG8_STAGE(PG8_SA(0, 1), cA + hstep, voffA);
        if (wr == 1) PG8_BAR;
        PG8_WAIT_V(2); PG8_BAR;
        PG8_STAGE(PG8_SB(1, 0), cB + kstep, voffB); PG8_STAGE(PG8_SA(1, 0), cA + kstep, voffA); PG8_STAGE(PG8_SB(1, 1), cB + hstep + kstep, voffB);
        PG8_WAIT_V(6); PG8_BAR;
    } else {
        PG8_STAGE(PG8_SB(0, 0), cB, voffB); PG8_STAGE(PG8_SA(0, 0), cA, voffA); PG8_STAGE(PG8_SB(0, 1), cB + hstep, voffB); PG8_STAGE(PG8_SA(0, 1), cA + hstep, voffA);
        if (wr == 1) PG8_BAR;
        PG8_WAIT_V(4); PG8_BAR;
        PG8_STAGE(PG8_SB(1, 0), cB + kstep, voffB); PG8_STAGE(PG8_SA(1, 0), cA + kstep, voffA); PG8_STAGE(PG8_SB(1, 1), cB + hstep + kstep, voffB);
        PG8_WAIT_V(6); PG8_BAR;
    }
    for (;;) {
        const bool has_next = S.next(ui + 1, nxt);
        const char* nA = has_next ? (const char*)g.A + (size_t)nxt.pm * tstep + (size_t)nxt.ks * K * 2 : cA; const char* nB = has_next ? (const char*)g.Bt + (size_t)nxt.pn * tstep + (size_t)nxt.ks * K * 2 : cB;
        for (int t = 0; t < nt; t += 2) {
            const bool last = (t == nt - 2);
            const char* a1 = cA + (size_t)(t + 1) * kstep;
            const char* a2 = last ? nA : cA + (size_t)(t + 2) * kstep; const char* b2 = last ? nB : cB + (size_t)(t + 2) * kstep;
            const char* a3 = a2 + kstep; const char* b3 = b2 + kstep;
            if (last && has_next) S.a_ready(nxt);
            if constexpr (SP2) {
            PG8_LDB(B0, 0, 0); PG8_LDB(B1, 0, 1); PG8_SCHED; PG8_LDA(At, 0, 0); PG8_STAGE(PG8_SA(1, 1), a1 + hstep, voffA);
            PG8_WAIT_V(8); PG8_WAIT_L(0); PG8_BAR; PG8_MMA(0, 0, At, B0); PG8_MMA(0, 1, At, B1); PG8_BAR; PG8_SCHED;
            PG8_LDA(At, 0, 1); PG8_STAGE(PG8_SB(0, 0), b2, voffB); PG8_STAGE(PG8_SB(0, 1), b2 + hstep, voffB); PG8_STAGE(PG8_SA(0, 0), a2, voffA);
            PG8_WAIT_V(8); PG8_WAIT_L(0); PG8_BAR; PG8_MMA(1, 0, At, B0); PG8_MMA(1, 1, At, B1); PG8_BAR; PG8_SCHED;
            PG8_LDB(B0, 1, 0); PG8_LDB(B1, 1, 1); PG8_SCHED; PG8_LDA(At, 1, 0); PG8_STAGE(PG8_SA(0, 1), a2 + hstep, voffA);
            PG8_WAIT_V(8); PG8_WAIT_L(0); PG8_BAR; PG8_MMA(0, 0, At, B0); PG8_MMA(0, 1, At, B1); PG8_BAR; PG8_SCHED;
            PG8_LDA(At, 1, 1); PG8_STAGE(PG8_SB(1, 0), b3, voffB); PG8_STAGE(PG8_SB(1, 1), b3 + hstep, voffB); PG8_STAGE(PG8_SA(1, 0), a3, voffA);
            PG8_WAIT_V(8); PG8_WAIT_L(0); PG8_BAR; PG8_MMA(1, 0, At, B0); PG8_MMA(1, 1, At, B1); PG8_BAR; PG8_SCHED;
            } else {
            PG8_LDB(B0, 0, 0); PG8_SCHED; PG8_LDA(At, 0, 0); PG8_STAGE(PG8_SA(1, 1), a1 + hstep, voffA);
            PG8_WAIT_L(8); PG8_BAR; PG8_WAIT_L(0); PG8_MMA(0, 0, At, B0); PG8_BAR; PG8_SCHED;
            PG8_LDB(B1, 0, 1); PG8_STAGE(PG8_SB(0, 0), b2, voffB);
            PG8_BAR; PG8_WAIT_L(0); PG8_MMA(0, 1, At, B1); PG8_BAR;
            PG8_LDA(At, 0, 1); PG8_STAGE(PG8_SA(0, 0), a2, voffA);
            PG8_BAR; PG8_WAIT_L(0); PG8_MMA(1, 0, At, B0); PG8_BAR; PG8_SCHED;
            PG8_STAGE(PG8_SB(0, 1), b2 + hstep, voffB);
            PG8_WAIT_V(6); PG8_BAR; PG8_MMA(1, 1, At, B1); PG8_BAR;
            PG8_LDB(B0, 1, 0); PG8_SCHED; PG8_LDA(At, 1, 0); PG8_STAGE(PG8_SA(0, 1), a2 + hstep, voffA);
            PG8_WAIT_L(8); PG8_BAR; PG8_WAIT_L(0); PG8_MMA(0, 0, At, B0); PG8_BAR; PG8_SCHED;
            PG8_LDB(B1, 1, 1); PG8_STAGE(PG8_SB(1, 0), b3, voffB);
            PG8_BAR; PG8_WAIT_L(0); PG8_MMA(0, 1, At, B1); PG8_BAR;
            PG8_LDA(At, 1, 1); PG8_STAGE(PG8_SA(1, 0), a3, voffA);
            PG8_BAR; PG8_WAIT_L(0); PG8_MMA(1, 0, At, B0); PG8_BAR; PG8_SCHED;
            PG8_STAGE(PG8_SB(1, 1), b3 + hstep, voffB);
            PG8_WAIT_V(6); PG8_BAR; PG8_MMA(1, 1, At, B1); PG8_BAR;
            }
        }
        if constexpr (ALIGN_EPI) { if (wr == 0) PG8_BAR; }
        if constexpr (!Epi::AFTER_DRAIN) { E(acc, cur, wr, wc, fr, fq); S.done(cur); }
        if (!has_next) break;
#pragma unroll
        for (int a = 0; a < 2; ++a)
#pragma unroll
            for (int b = 0; b < 2; ++b)
#pragma unroll
                for (int m = 0; m < 4; ++m)
#pragma unroll
                    for (int n = 0; n < 2; ++n) acc[a][b][m][n] = (f32x4){0.f, 0.f, 0.f, 0.f};
        cur = nxt; cA = nA; cB = nB; ++ui;
        if constexpr (ALIGN_EPI) { if (wr == 1) PG8_BAR; }
    }
    PG8_WAIT_V(0);
    if constexpr (!ALIGN_EPI) { if (wr == 0) PG8_BAR; }
    PG8_BAR;
    if constexpr (Epi::AFTER_DRAIN) { E.fused(acc, cur, wr, wc, fr, fq, lds, wid, lane); S.done(cur); }
#undef PG8_SA
#undef PG8_SB
#undef PG8_STAGE
#undef PG8_LDA
#undef PG8_LDB
#undef PG8_MMA
#undef PG8_WAIT_V
#undef PG8_WAIT_L
#undef PG8_BAR
#undef PG8_SCHED
}
}

#define LAS __attribute__((address_space(3)))
typedef unsigned short bf16;
typedef short bf16x8 __attribute__((ext_vector_type(8)));
typedef float f32x4 __attribute__((ext_vector_type(4)));
typedef unsigned u32x4 __attribute__((ext_vector_type(4)));
typedef unsigned u32x2 __attribute__((ext_vector_type(2)));

constexpr int NWAVES = 8, NTHR = 512;
constexpr int D = 2048, SEQ = 8192, CTXL = 256, ML = 16384, MT = 16896;
constexpr int BW = 768, BCOLS = 2688, INC = 6016, INCP = 6144, ZB0 = 1024, ZC0 = 3712, DFF = 8192, NH = 12, SL = 8448;
constexpr int NMOD = 12288;
constexpr float ALPHA = 1.41421356237f;
constexpr float LN_EPS = 1e-5f, GN_EPS = 64e-5f;

constexpr size_t MiB = 1u << 20;
constexpr size_t WS_CTL = 0, CTL_BYTES = 352 * 1024;
constexpr size_t WS_WIN = 1 * MiB, WS_WOUT = 25 * MiB, WS_WUP = 33 * MiB, WS_WDN = 65 * MiB, WS_SMALL = 97 * MiB;
constexpr size_t WS_XC = 99 * MiB, WS_AC = 103 * MiB, WS_Z = 169 * MiB, WS_SOP = 367 * MiB, WS_Y = 590 * MiB, WS_G = 640 * MiB, WS_BV = 665 * MiB, WS_END = 690 * MiB;
constexpr size_t WS_SLAB = 440 * MiB;
constexpr size_t WS_HM = WS_Z;
constexpr size_t SM_W2T = 0, SM_A2T = 98304, SM_G2T = 196608, SM_GMWS = 294912;
constexpr int LDS_BYTES = 147456;

#define LDS_WAIT() asm volatile("s_waitcnt lgkmcnt(0)" ::: "memory")
__device__ __forceinline__ unsigned f2bf(float f) { unsigned u = __builtin_bit_cast(unsigned, f); return (u + 0x7fffu + ((u >> 16) & 1u)) >> 16; }
__device__ __forceinline__ unsigned pk2(float lo, float hi) { return f2bf(lo) | (f2bf(hi) << 16); }
__device__ __forceinline__ float bflo(unsigned w) { return __builtin_bit_cast(float, w << 16); }
__device__ __forceinline__ float bfhi(unsigned w) { return __builtin_bit_cast(float, w & 0xffff0000u); }
__device__ __forceinline__ float bf1(bf16 h) { return __builtin_bit_cast(float, ((unsigned)h) << 16); }
__device__ __forceinline__ float sigmoid_f(float x) { return __builtin_amdgcn_rcpf(1.f + __expf(-x)); }
__device__ __forceinline__ float silu_f(float x) { return x * __builtin_amdgcn_rcpf(1.f + __expf(-x)); }
__device__ __forceinline__ float tanh_f(float x) { const float e = __expf(2.f * x); return 1.f - 2.f * __builtin_amdgcn_rcpf(e + 1.f); }
__device__ __forceinline__ float gelu_f(float x) { const float y = 0.7978845608f * (x + 0.044715f * x * x * x); return 0.5f * x * (1.f + tanh_f(y)); }
__device__ __forceinline__ float wave_sum(float v) {
#pragma unroll
    for (int o = 1; o < 64; o <<= 1) v += __shfl_xor(v, o);
    return v;
}
template <int CTRL> __device__ __forceinline__ float dpp_mov(float x) { return __builtin_bit_cast(float, __builtin_amdgcn_update_dpp(0, __builtin_bit_cast(int, x), CTRL, 0xf, 0xf, true)); }
__device__ __forceinline__ float allreduce16(float x) {
    x += dpp_mov<0x128>(x); x += dpp_mov<0x124>(x); x += dpp_mov<0x122>(x); x += dpp_mov<0x121>(x); return x;
}
#define MFMA16(a, b, c) __builtin_amdgcn_mfma_f32_16x16x32_bf16((a), (b), (c), 0, 0, 0)

template <int ACT> struct EpiStoreBf16 {
    static constexpr bool PERM = true, AFTER_DRAIN = false;
    bf16* O; int ldc;
    __device__ __forceinline__ void operator()(const pg8::f32x4 (&acc)[2][2][4][2], const pg8::Unit& u, int wr, int wc, int fr, int fq) const {
        const int row0 = u.pm * 256 + wr * 64 + fr, col0 = u.pn * 256 + wc * 32 + 8 * fq;
#pragma unroll
        for (int ai = 0; ai < 2; ++ai)
#pragma unroll
            for (int m = 0; m < 4; ++m) { bf16* rowp = O + (size_t)(row0 + ai * 128 + m * 16) * ldc + col0;
#pragma unroll
                for (int bj = 0; bj < 2; ++bj) { pg8::f32x4 v0 = acc[ai][bj][m][0], v1 = acc[ai][bj][m][1];
                    if (ACT == 1) {
#pragma unroll
                        for (int e = 0; e < 4; ++e) { float a = fmaxf(v0[e], 0.f), b = fmaxf(v1[e], 0.f); v0[e] = a * a; v1[e] = b * b; } }
                    u32x4 w; w.x = pg8::cvt_pk_bf16(v0[0], v0[1]); w.y = pg8::cvt_pk_bf16(v0[2], v0[3]); w.z = pg8::cvt_pk_bf16(v1[0], v1[1]); w.w = pg8::cvt_pk_bf16(v1[2], v1[3]);
                    *(u32x4*)(rowp + bj * 128) = w; } }
    }
};
struct EpiRes {
    static constexpr bool PERM = false, AFTER_DRAIN = false;
    const float* srcL; const float* srcC; float* dstL; float* dstC; const float* gate;
    __device__ __forceinline__ void operator()(const pg8::f32x4 (&acc)[2][2][4][2], const pg8::Unit& u, int wr, int wc, int fr, int fq) const {
        const int R0 = u.pm * 256; const float* src; float* dst; int mv;
        if (R0 < ML) { src = srcL + (size_t)R0 * D; dst = dstL + (size_t)R0 * D; mv = (R0 >= SEQ) ? 1 : 0; }
        else { src = srcC + (size_t)(R0 - ML) * D; dst = dstC + (size_t)(R0 - ML) * D; mv = 2; }
        const int col0 = u.pn * 256 + wc * 32 + 4 * fq; const float* gt = gate + mv * NMOD + col0;
        pg8::f32x4 gv[2][2];
#pragma unroll
        for (int bj = 0; bj < 2; ++bj)
#pragma unroll
            for (int n = 0; n < 2; ++n) gv[bj][n] = *(const pg8::f32x4*)(gt + bj * 128 + n * 16);
#pragma unroll
        for (int ai = 0; ai < 2; ++ai)
#pragma unroll
            for (int m = 0; m < 4; ++m) { const size_t off = (size_t)(wr * 64 + fr + ai * 128 + m * 16) * D + col0;
#pragma unroll
                for (int bj = 0; bj < 2; ++bj)
#pragma unroll
                    for (int n = 0; n < 2; ++n) { const pg8::f32x4 s = *(const pg8::f32x4*)(src + off + bj * 128 + n * 16);
                        *(pg8::f32x4*)(dst + off + bj * 128 + n * 16) = s * ALPHA + gv[bj][n] * acc[ai][bj][m][n]; }
                asm volatile("" ::: "memory"); }
    }
};

struct EpiSlabCtx {
    static constexpr bool PERM = false, AFTER_DRAIN = false;
    float* slab; const float* gate; int ldn;
    __device__ __forceinline__ void operator()(const pg8::f32x4 (&acc)[2][2][4][2], const pg8::Unit& u, int wr, int wc, int fr, int fq) const {
        const int col0 = u.pn * 256 + wc * 32 + 4 * fq;
        float* dst = slab + ((size_t)u.ks * (2 * CTXL) + u.pm * 256) * ldn;
#pragma unroll
        for (int bj = 0; bj < 2; ++bj)
#pragma unroll
            for (int n = 0; n < 2; ++n) { const pg8::f32x4 gv = gate ? *(const pg8::f32x4*)(gate + col0 + bj * 128 + n * 16) : (pg8::f32x4){1.f, 1.f, 1.f, 1.f};
#pragma unroll
                for (int ai = 0; ai < 2; ++ai)
#pragma unroll
                    for (int m = 0; m < 4; ++m) *(pg8::f32x4*)(dst + (size_t)(wr * 64 + fr + ai * 128 + m * 16) * ldn + col0 + bj * 128 + n * 16) = gv * acc[ai][bj][m][n]; }
    }
};
struct SplitKOrder {
    int nM, nN, nS, G, c;
    __device__ __forceinline__ bool next(int i, pg8::Unit& u) const { const int L = i * G + c; if (L >= nM * nN * nS) return false; u.ks = L % nS; const int t = L / nS; u.pm = t % nM; u.pn = t / nM; return true; }
    __device__ __forceinline__ void a_ready(const pg8::Unit&) const {}
    __device__ __forceinline__ void done(const pg8::Unit&) const {}
};

__device__ __forceinline__ void transpose_item(const float* W, int K, int N, bf16* WT, int row_off, LAS float* scr, int item, int lane) {
    const int nblk = N / 32, kb = item / nblk, nb = item % nblk, k0 = 64 * kb, n0 = 32 * nb;
#pragma unroll 8
    for (int i = 0; i < 32; ++i) { const int kk = 2 * i + (lane >> 5); scr[kk * 33 + (lane & 31)] = W[(size_t)(k0 + kk) * N + n0 + (lane & 31)]; }
    LDS_WAIT(); asm volatile("" ::: "memory");
    const int c = lane & 7;
#pragma unroll
    for (int j = 0; j < 4; ++j) { const int n = (lane >> 3) + 8 * j; const LAS float* s = scr + (8 * c) * 33 + n;
        u32x4 o; o.x = pk2(s[0 * 33], s[1 * 33]); o.y = pk2(s[2 * 33], s[3 * 33]); o.z = pk2(s[4 * 33], s[5 * 33]); o.w = pk2(s[6 * 33], s[7 * 33]);
        *(u32x4*)(WT + (size_t)(row_off + n0 + n) * K + k0 + 8 * c) = o; }
    LDS_WAIT(); asm volatile("" ::: "memory");
}
struct In { const float* p[28]; };
__device__ __forceinline__ void convert_weights(const In& in, int l, int part, unsigned char* ws, LAS unsigned char* lds, int gw, int NGW, int wave, int lane) {
    LAS float* scr = (LAS float*)(lds + wave * 16384);
    constexpr int I_IN = 32 * 188, I_OUT = 32 * 64, I_UP = 32 * 256, I_DN = 128 * 64, I_L = 24;
    bf16* small = (bf16*)(ws + WS_SMALL);
    if (part == 0 || part == 2 || part == 3) {
        constexpr int NITEMS = I_IN + 4 * I_L + 2 * I_L;
        if (part != 3) for (int it = gw; it < NITEMS; it += NGW) {
            int r = it;
            if (r < I_IN) { transpose_item(in.p[6] + (size_t)l * D * INC, D, INC, (bf16*)(ws + WS_WIN), 0, scr, r, lane); continue; } r -= I_IN;
            if (r < 2 * I_L) { const int d = r / I_L; transpose_item(in.p[11] + (size_t)(l * 2 + d) * 64 * BW, 64, BW, small + SM_W2T + d * BW * 64, 0, scr, r % I_L, lane); continue; } r -= 2 * I_L;
            if (r < 2 * I_L) { const int d = r / I_L; transpose_item(in.p[13] + (size_t)(l * 2 + d) * 64 * BW, 64, BW, small + SM_A2T + d * BW * 64, 0, scr, r % I_L, lane); continue; } r -= 2 * I_L;
            transpose_item(in.p[14] + (size_t)l * 128 * BW, 128, BW, small + SM_G2T, 0, scr, r, lane);
        }
        if (part == 2) return;
        const int gt = gw * 64 + lane, NT = NGW * 64;
        const float* gm = in.p[7] + (size_t)l * 131072;
        for (int i = gt; i < 131072 / 4; i += NT) { const f32x4 v = *(const f32x4*)(gm + 4 * i); u32x2 o; o.x = pk2(v.x, v.y); o.y = pk2(v.z, v.w); *(u32x2*)(small + SM_GMWS + 4 * i) = o; }
        u32x4* padp = (u32x4*)((bf16*)(ws + WS_WIN) + (size_t)INC * D);
        for (int i = gt; i < 128 * D / 8; i += NT) padp[i] = (u32x4){0u, 0u, 0u, 0u};
    } else {
        constexpr int NITEMS = I_OUT + I_UP + I_DN;
        for (int it = gw; it < NITEMS; it += NGW) {
            int r = it;
            if (r < I_OUT) { transpose_item(in.p[21] + (size_t)l * D * D, D, D, (bf16*)(ws + WS_WOUT), 0, scr, r, lane); continue; } r -= I_OUT;
            if (r < I_UP) { transpose_item(in.p[24] + (size_t)l * D * DFF, D, DFF, (bf16*)(ws + WS_WUP), 0, scr, r, lane); continue; } r -= I_UP;
            transpose_item(in.p[25] + (size_t)l * DFF * D, DFF, D, (bf16*)(ws + WS_WDN), 0, scr, r, lane);
        }
    }
}
__device__ __forceinline__ void mod_gemv(const In& in, float* mod, int gw, int NGW, int lane) {
    for (int it = gw; it < 2 * 48 * 16; it += NGW) {
        const int l = it / 768, r = it % 768, cgi = r >> 4, ks = r & 15;
        const float* W = in.p[4] + (size_t)l * D * NMOD + (size_t)(ks * 128) * NMOD + cgi * 256 + lane * 4;
        const float* c0 = in.p[1] + ks * 128; const float* c1 = in.p[1] + D + ks * 128; const float* c2 = in.p[3] + ks * 128;
        f32x4 a0 = {0.f, 0.f, 0.f, 0.f}, a1 = a0, a2 = a0;
#pragma unroll 8
        for (int k = 0; k < 128; ++k) { const f32x4 w = *(const f32x4*)(W + (size_t)k * NMOD);
            const float s0 = silu_f(c0[k]), s1 = silu_f(c1[k]), s2 = silu_f(c2[k]);
            a0 += w * s0; a1 += w * s1; a2 += w * s2; }
        if (ks == 0) { const f32x4 bv = *(const f32x4*)(in.p[5] + (size_t)l * NMOD + cgi * 256 + lane * 4); a0 += bv; a1 += bv; a2 += bv; }
        float* mo = mod + (size_t)l * 3 * NMOD + cgi * 256 + lane * 4;
#pragma unroll
        for (int e = 0; e < 4; ++e) { atomicAdd(mo + e, a0[e]); atomicAdd(mo + NMOD + e, a1[e]); atomicAdd(mo + 2 * NMOD + e, a2[e]); }
    }
}
__device__ __forceinline__ void rowwise(int gw, int NGW, int lane, int nrows, const float* srcL, const float* srcC, float* dstL, float* dstC,
                                        bool do_ln, const float* lng, const float* lnb, bool do_mod, const float* modl, int shc, int scc, bf16* aout, const float* slab = nullptr, int nslab = 0) {
    f32x4 nv[8];
    if (gw < nrows) { const float* s0_ = (gw < ML) ? srcL + (size_t)gw * D : srcC + (size_t)(gw - ML) * D;
#pragma unroll
        for (int j = 0; j < 8; ++j) nv[j] = *(const f32x4*)(s0_ + lane * 4 + 256 * j); }
    for (int m = gw; m < nrows; m += NGW) {
        float* dst; int mv;
        if (m < ML) { dst = dstL + (size_t)m * D; mv = (m >= SEQ) ? 1 : 0; }
        else { dst = dstC + (size_t)(m - ML) * D; mv = 2; }
        f32x4 v[8];
#pragma unroll
        for (int j = 0; j < 8; ++j) v[j] = nv[j];
        { const int mn = m + NGW;
          if (mn < nrows) { const float* s1_ = (mn < ML) ? srcL + (size_t)mn * D : srcC + (size_t)(mn - ML) * D;
#pragma unroll
              for (int j = 0; j < 8; ++j) nv[j] = *(const f32x4*)(s1_ + lane * 4 + 256 * j); } }
        if (nslab > 0 && m >= ML) {
#pragma unroll
            for (int j = 0; j < 8; ++j) v[j] = v[j] * ALPHA;
            for (int sidx = 0; sidx < nslab; ++sidx) { const float* sp = slab + ((size_t)sidx * (2 * CTXL) + (m - ML)) * D + lane * 4;
#pragma unroll
                for (int j = 0; j < 8; ++j) v[j] += *(const f32x4*)(sp + 256 * j); }
        }
        if (do_ln) {
            float s = 0.f;
#pragma unroll
            for (int j = 0; j < 8; ++j) s += (v[j].x + v[j].y) + (v[j].z + v[j].w);
            const float mean = wave_sum(s) * (1.f / D); float s2 = 0.f;
#pragma unroll
            for (int j = 0; j < 8; ++j) { v[j] = v[j] - mean; s2 += (v[j].x * v[j].x + v[j].y * v[j].y) + (v[j].z * v[j].z + v[j].w * v[j].w); }
            const float rstd = rsqrtf(wave_sum(s2) * (1.f / D) + LN_EPS);
#pragma unroll
            for (int j = 0; j < 8; ++j) { const f32x4 gg = *(const f32x4*)(lng + lane * 4 + 256 * j), bb = *(const f32x4*)(lnb + lane * 4 + 256 * j);
                v[j] = v[j] * rstd * gg + bb; *(f32x4*)(dst + lane * 4 + 256 * j) = v[j]; }
        }
        if (do_mod) {
            const float* sh = modl + mv * NMOD + shc * D; const float* sc = modl + mv * NMOD + scc * D;
#pragma unroll
            for (int j = 0; j < 8; ++j) { const f32x4 s1 = *(const f32x4*)(sc + lane * 4 + 256 * j), h1 = *(const f32x4*)(sh + lane * 4 + 256 * j);
                const f32x4 a = v[j] * (s1 + 1.f) + h1; u32x2 o; o.x = pk2(a.x, a.y); o.y = pk2(a.z, a.w);
                *(u32x2*)(aout + (size_t)m * D + lane * 4 + 256 * j) = o; }
        }
    }
}

__device__ __forceinline__ f32x4 bf4(u32x2 w) { return (f32x4){bflo(w.x), bfhi(w.x), bflo(w.y), bfhi(w.y)}; }
__device__ __forceinline__ void rwkv_proj_phase(const bf16* Z, const float* shift, const float* w0, const float* a0, const float* kkp, const float* kap, const float* rkp,
                                                const bf16* w2T, const bf16* a2T, const bf16* g2T, bf16* SOP, bf16* G, bf16* BV, LAS unsigned char* lds, int tid, int wave, int lane) {
    for (int it = blockIdx.x; it < 132 * 3; it += gridDim.x) {
        int fr = lane & 15, g = lane >> 4;
        asm volatile("" : "+v"(fr), "+v"(g));
        const int tt = it / 3, hg = it % 3;
        const int m = tt * 128 + wave * 16 + fr;
        int b, tpos, len, s;
        if (m < ML) { b = m >> 13; tpos = m & 8191; len = SEQ; s = CTXL + tpos; } else { b = (m - ML) >> 8; tpos = (m - ML) & 255; len = CTXL; s = tpos; }
        const bool hp = tpos > 0, hn = tpos < len - 1;
        const long offm = hp ? -(long)INCP : 0, offp = hn ? (long)INCP : 0; const float fm = hp ? 1.f : 0.f, fn = hn ? 1.f : 0.f;
        const bf16* zr = Z + (size_t)m * INCP + ZB0;
        bf16x8 xf[12];
#pragma unroll
        for (int ks = 0; ks < 12; ++ks) {
            const int col = 2304 + 32 * ks + 8 * g;
            const u32x4 c0 = *(const u32x4*)(zr + col), cm = *(const u32x4*)(zr + offm + col), cp = *(const u32x4*)(zr + offp + col);
            float val[8];
#pragma unroll
            for (int q = 0; q < 2; ++q) { const f32x4 t0 = *(const f32x4*)(shift + col + 4 * q) * fm, t1 = *(const f32x4*)(shift + BCOLS + col + 4 * q), t2 = *(const f32x4*)(shift + 2 * BCOLS + col + 4 * q) * fn;
                const unsigned m0 = q ? cm.z : cm.x, m1 = q ? cm.w : cm.y, z0 = q ? c0.z : c0.x, z1 = q ? c0.w : c0.y, p0 = q ? cp.z : cp.x, p1 = q ? cp.w : cp.y;
                val[4 * q + 0] = t0.x * bflo(m0) + t1.x * bflo(z0) + t2.x * bflo(p0);
                val[4 * q + 1] = t0.y * bfhi(m0) + t1.y * bfhi(z0) + t2.y * bfhi(p0);
                val[4 * q + 2] = t0.z * bflo(m1) + t1.z * bflo(z1) + t2.z * bflo(p1);
                val[4 * q + 3] = t0.w * bfhi(m1) + t1.w * bfhi(z1) + t2.w * bfhi(p1); }
#pragma unroll
            for (int e = 0; e < 8; ++e) { if (ks < 4) val[e] = tanh_f(val[e]); else if (ks >= 8) val[e] = sigmoid_f(val[e]); }
            u32x4 pk; pk.x = pk2(val[0], val[1]); pk.y = pk2(val[2], val[3]); pk.z = pk2(val[4], val[5]); pk.w = pk2(val[6], val[7]);
            xf[ks] = __builtin_bit_cast(bf16x8, pk);
            if (ks & 1) asm volatile("" ::: "memory");
        }
#pragma unroll 1
        for (int hh = 0; hh < 4; ++hh) {
            const int h = hg * 4 + hh;
            asm volatile("" : "+v"(fr), "+v"(g));
            __syncthreads();
            {
#pragma unroll 2
                for (int i = 0; i < 6; ++i) { const int cid = tid + 512 * i, tok = cid / 24, ch = cid % 24, wh = ch >> 3, col = wh * BW + h * 64 + (ch & 7) * 8;
                    const int mm = tt * 128 + tok; int tp, ln; if (mm < ML) { tp = mm & 8191; ln = SEQ; } else { tp = (mm - ML) & 255; ln = CTXL; }
                    const bool hp_ = tp > 0, hn_ = tp < ln - 1; const float fm_ = hp_ ? 1.f : 0.f, fn_ = hn_ ? 1.f : 0.f;
                    const bf16* zz = Z + (size_t)mm * INCP + ZB0 + col;
                    const u32x4 c0 = *(const u32x4*)zz, cm = *(const u32x4*)(zz - (hp_ ? INCP : 0)), cp = *(const u32x4*)(zz + (hn_ ? INCP : 0));
                    float val[8];
#pragma unroll
                    for (int qq = 0; qq < 2; ++qq) { const f32x4 t0 = *(const f32x4*)(shift + col + 4 * qq) * fm_, t1 = *(const f32x4*)(shift + BCOLS + col + 4 * qq), t2 = *(const f32x4*)(shift + 2 * BCOLS + col + 4 * qq) * fn_;
                        const unsigned m0 = qq ? cm.z : cm.x, m1 = qq ? cm.w : cm.y, z0 = qq ? c0.z : c0.x, z1 = qq ? c0.w : c0.y, p0 = qq ? cp.z : cp.x, p1 = qq ? cp.w : cp.y;
                        val[4 * qq + 0] = t0.x * bflo(m0) + t1.x * bflo(z0) + t2.x * bflo(p0);
                        val[4 * qq + 1] = t0.y * bfhi(m0) + t1.y * bfhi(z0) + t2.y * bfhi(p0);
                        val[4 * qq + 2] = t0.z * bflo(m1) + t1.z * bflo(z1) + t2.z * bflo(p1);
                        val[4 * qq + 3] = t0.w * bfhi(m1) + t1.w * bfhi(z1) + t2.w * bfhi(p1); }
                    u32x4 pk; pk.x = pk2(val[0], val[1]); pk.y = pk2(val[2], val[3]); pk.z = pk2(val[4], val[5]); pk.w = pk2(val[6], val[7]);
                    *(LAS u32x4*)(lds + tok * 400 + ch * 16) = pk; }
#pragma unroll
                for (int i = 0; i < 6; ++i) { const int cid = tid + 512 * i;
                    if (i < 4) { const int cc = cid & 1023, dd = cc >> 9, n = (cc >> 3) & 63, c8 = cc & 7; const bf16* src = ((i < 2) ? w2T : a2T) + ((size_t)(dd * BW + h * 64 + n) * 64 + c8 * 8);
                        *(LAS u32x4*)(lds + 51200 + ((i < 2) ? 0 : 18432) + (dd * 64 + n) * 144 + c8 * 16) = *(const u32x4*)src; }
                    else { const int cc = cid - 2048, n = cc >> 4, c8 = cc & 15; *(LAS u32x4*)(lds + 51200 + 36864 + n * 272 + c8 * 16) = *(const u32x4*)(g2T + ((size_t)(h * 64 + n) * 128 + c8 * 8)); } }
            }
            __syncthreads();
            const LAS unsigned char* rkv = lds + (wave * 16 + fr) * 400 + 8 * g;
            f32x4 kc[4]; float ss = 0.f;
#pragma unroll
            for (int nb = 0; nb < 4; ++nb) {
                const int c = h * 64 + nb * 16 + 4 * g;
                kc[nb] = bf4(*(const LAS u32x2*)(rkv + 128 + nb * 32));
                const f32x4 t = kc[nb] * *(const f32x4*)(kkp + c);
                ss += (t.x * t.x + t.y * t.y) + (t.z * t.z + t.w * t.w);
            }
            ss += __shfl_xor(ss, 16); ss += __shfl_xor(ss, 32);
            const float inv = rsqrtf(fmaxf(ss, 1e-12f));
            bf16* sp = SOP + ((size_t)((b * NH + h) * SL + s)) * 576 + 4 * g;
            float bon = 0.f;
#pragma unroll
            for (int nb = 0; nb < 4; ++nb) {
                const int n = h * 64 + nb * 16 + fr;
                f32x4 accw[2], acca[2], accg = (f32x4){0.f, 0.f, 0.f, 0.f};
#pragma unroll
                for (int d = 0; d < 2; ++d) { accw[d] = (f32x4){0.f, 0.f, 0.f, 0.f}; acca[d] = (f32x4){0.f, 0.f, 0.f, 0.f};
#pragma unroll
                    for (int ksl = 0; ksl < 2; ++ksl) {
                        const bf16x8 wf = *(const LAS bf16x8*)(lds + 51200 + (d * 64 + nb * 16 + fr) * 144 + (32 * ksl + 8 * g) * 2);
                        const bf16x8 af = *(const LAS bf16x8*)(lds + 51200 + 18432 + (d * 64 + nb * 16 + fr) * 144 + (32 * ksl + 8 * g) * 2);
                        accw[d] = MFMA16(wf, xf[2 * d + ksl], accw[d]);
                        acca[d] = MFMA16(af, xf[4 + 2 * d + ksl], acca[d]); } }
#pragma unroll
                for (int ksl = 0; ksl < 4; ++ksl) { const bf16x8 gf = *(const LAS bf16x8*)(lds + 51200 + 36864 + (nb * 16 + fr) * 272 + (32 * ksl + 8 * g) * 2); accg = MFMA16(gf, xf[8 + ksl], accg); }
                const int c = h * 64 + nb * 16 + 4 * g;
                const f32x4 rc = bf4(*(const LAS u32x2*)(rkv + nb * 32)), vc = bf4(*(const LAS u32x2*)(rkv + 256 + nb * 32));
                const f32x4 w00 = *(const f32x4*)(w0 + c), w01 = *(const f32x4*)(w0 + BW + c), a00 = *(const f32x4*)(a0 + c), a01 = *(const f32x4*)(a0 + BW + c);
                const f32x4 kk4 = *(const f32x4*)(kkp + c), ka4 = *(const f32x4*)(kap + c), rk4 = *(const f32x4*)(rkp + c);
                float o[9][4];
#pragma unroll
                for (int e = 0; e < 4; ++e) {
                    const float ad0 = sigmoid_f(a00[e] + acca[0][e]), ad1 = sigmoid_f(a01[e] + acca[1][e]);
                    const float lw0 = -0.60653066f * sigmoid_f(w00[e] + accw[0][e]), lw1 = -0.60653066f * sigmoid_f(w01[e] + accw[1][e]);
                    const float k = kc[nb][e], kk = k * kk4[e] * inv;
                    const float kd0 = k * (1.f + (ad0 - 1.f) * ka4[e]), kd1 = k * (1.f + (ad1 - 1.f) * ka4[e]);
                    bon += rc[e] * (kd0 + kd1) * rk4[e];
                    o[0][e] = rc[e]; o[1][e] = vc[e]; o[2][e] = -kk; o[3][e] = lw0; o[4][e] = kd0; o[5][e] = kk * ad0; o[6][e] = lw1; o[7][e] = kd1; o[8][e] = kk * ad1;
                }
#pragma unroll
                for (int vv = 0; vv < 9; ++vv) { u32x2 w; w.x = pk2(o[vv][0], o[vv][1]); w.y = pk2(o[vv][2], o[vv][3]); *(u32x2*)(sp + vv * 64 + nb * 16) = w; }
                { u32x2 w; w.x = pk2(accg[0], accg[1]); w.y = pk2(accg[2], accg[3]); *(u32x2*)(G + (size_t)m * BW + c) = w; }
            }
            bon += __shfl_xor(bon, 16); bon += __shfl_xor(bon, 32);
#pragma unroll
            for (int nb = 0; nb < 4; ++nb) { const int c = h * 64 + nb * 16 + 4 * g;
                const f32x4 t = bf4(*(const LAS u32x2*)(rkv + 256 + nb * 32)) * bon;
                u32x2 w; w.x = pk2(t.x, t.y); w.y = pk2(t.z, t.w); *(u32x2*)(BV + (size_t)m * BW + c) = w; }
            asm volatile("" ::: "memory");
        }
    }
}

#ifndef SCAN_NCW
#define SCAN_NCW 4
#endif
constexpr int NCW = SCAN_NCW, RPB = 4 * NCW, BPH = 64 / RPB, SCAN_BLOCKS = 48 * BPH, TT = 32, NTILE = SL / TT;
struct StepOps { f32x4 r, a, w, k, b; float v; };
typedef float f32x2 __attribute__((ext_vector_type(2)));
template <int DIR> __device__ __forceinline__ void scan_tile(const LAS float* opq, const LAS float* opv, LAS float* ybq, f32x2& Sx, f32x2& Sy) {
#define TR(i) (DIR ? (TT - 1 - (i)) : (i))
#define SCAN_LOAD(o, i) do { const LAS float* bp = opq + TR(i) * 384; \
        o.r = *(const LAS f32x4*)(bp); o.a = *(const LAS f32x4*)(bp + 128); o.w = *(const LAS f32x4*)(bp + 192); o.k = *(const LAS f32x4*)(bp + 256); o.b = *(const LAS f32x4*)(bp + 320); \
        o.v = opv[TR(i) * 384]; asm volatile("" ::: "memory"); } while (0)
#define SCAN_STEP(o, i) do { \
        f32x2 t_ = Sx * o.a.lo; t_ = Sy * o.a.hi + t_; float sa = t_.x + t_.y; sa = allreduce16(sa); \
        const f32x2 kx_ = o.k.lo * o.v, ky_ = o.k.hi * o.v; \
        Sx = Sx * o.w.lo + (o.b.lo * sa + kx_); Sy = Sy * o.w.hi + (o.b.hi * sa + ky_); \
        f32x2 u_ = Sx * o.r.lo; u_ = Sy * o.r.hi + u_; float yv_ = u_.x + u_.y; yv_ += dpp_mov<0x128>(yv_); ybq[TR(i) * RPB * 8] = yv_; asm volatile("" ::: "memory"); } while (0)
    StepOps X0, X1, X2, X3;
    SCAN_LOAD(X0, 0); SCAN_LOAD(X1, 1);
#pragma unroll
    for (int i = 0; i < TT; i += 4) {
        SCAN_LOAD(X2, i + 2); SCAN_STEP(X0, i);
        SCAN_LOAD(X3, i + 3); SCAN_STEP(X1, i + 1);
        if (i + 4 < TT) SCAN_LOAD(X0, i + 4);
        SCAN_STEP(X2, i + 2);
        if (i + 4 < TT) SCAN_LOAD(X1, i + 5);
        SCAN_STEP(X3, i + 3);
    }
#undef TR
#undef SCAN_LOAD
#undef SCAN_STEP
}
__device__ __forceinline__ void scan_block(int pair, int part, const bf16* SOP, bf16* Y, LAS unsigned char* lds, int tid, int wave, int lane, int pf = 3) {
    static_assert(NCW == 4, "waves 0-3 compute, waves 4-7 stage operands and write y out");
    const int d = pair / 24, b = (pair % 24) / 12, h = pair % 12;
    LAS float* op0 = (LAS float*)lds;
    LAS float* op1 = (LAS float*)(lds + 49152);
    LAS float* yb0 = (LAS float*)(lds + 98304);
    LAS float* yb1 = (LAS float*)(lds + 98304 + 32 * RPB * 8 * 4);
    const int q = lane & 15, rl = (wave & 3) * 4 + (lane >> 4);
    const bf16* sbase = SOP + (size_t)((b * NH + h) * SL) * 576;
    const int ht = tid - 256, part8 = ht & 7, stok = ht >> 3;
    u32x4 sa_[6], sb_[6];
#define SCAN_S0(j) (d == 0 ? TT * (j) : ((j) < 8 ? CTXL - TT * ((j) + 1) : SL - TT * ((j) - 8 + 1)))
#define SCAN_ISSUE(dst, j) do { const bf16* sp_ = sbase + ((size_t)SCAN_S0(j) + stok) * 576 + part8 * 8; \
        _Pragma("unroll") for (int i = 0; i < 6; ++i) dst[i] = *(const u32x4*)(sp_ + ((i < 3) ? i : 3 + 3 * d + (i - 3)) * 64); } while (0)
#define SCAN_STAGE(src, opb) do { _Pragma("unroll") for (int i = 0; i < 6; ++i) { \
            f32x4 lo = {bflo(src[i].x), bfhi(src[i].x), bflo(src[i].y), bfhi(src[i].y)}, hi = {bflo(src[i].z), bfhi(src[i].z), bflo(src[i].w), bfhi(src[i].w)}; \
            if (i == 3) { lo.x = __expf(lo.x); lo.y = __expf(lo.y); lo.z = __expf(lo.z); lo.w = __expf(lo.w); hi.x = __expf(hi.x); hi.y = __expf(hi.y); hi.z = __expf(hi.z); hi.w = __expf(hi.w); } \
            LAS float* dp = opb + (stok * 6 + i) * 64 + part8 * 8; *(LAS f32x4*)dp = lo; *(LAS f32x4*)(dp + 4) = hi; } } while (0)
#define SCAN_BAR() do { asm volatile("s_waitcnt lgkmcnt(0)" ::: "memory"); __builtin_amdgcn_s_barrier(); asm volatile("" ::: "memory"); } while (0)
#define SCAN_YOUT(ybuf, j) do { const int s0_ = SCAN_S0(j); _Pragma("unroll") for (int i = 0; i < RPB / 8; ++i) { const int idx = ht + 256 * i, tok = idx / RPB, r = idx % RPB; const LAS f32x4* yp = (const LAS f32x4*)(ybuf + idx * 8); \
            const f32x4 t = yp[0] + yp[1]; \
            Y[((size_t)((d * 2 + b) * SL + s0_ + tok)) * BW + h * 64 + part * RPB + r] = (bf16)f2bf((t.x + t.y) + (t.z + t.w)); } } while (0)
#define SCAN_TILE(nxt, j, opc, opn, ybc, ybp) do { \
        if (wave < 4) { if (!(pf & 4)) { \
            if (d == 0) scan_tile<0>(opc + 4 * q, opc + 64 + part * RPB + rl, ybc + rl * 8 + (q & 7), Sx, Sy); \
            else        scan_tile<1>(opc + 4 * q, opc + 64 + part * RPB + rl, ybc + rl * 8 + (q & 7), Sx, Sy); } \
        } else { \
            if ((j) + 1 < NTILE) SCAN_STAGE(nxt, opn); \
            if ((j) + 3 < NTILE) SCAN_ISSUE(nxt, (j) + 3); \
            if ((j) > 0) SCAN_YOUT(ybp, (j) - 1); } \
        SCAN_BAR(); } while (0)
    f32x2 Sx = {0.f, 0.f}, Sy = {0.f, 0.f};
    if (wave < 4) __builtin_amdgcn_s_setprio(3);
    if (wave >= 4) { SCAN_ISSUE(sa_, 0); SCAN_ISSUE(sb_, 1); SCAN_STAGE(sa_, op0); SCAN_ISSUE(sa_, 2); }
    SCAN_BAR();
#pragma unroll 1
    for (int j = 0; j < NTILE; j += 2) { SCAN_TILE(sb_, j, op0, op1, yb0, yb1); SCAN_TILE(sa_, j + 1, op1, op0, yb1, yb0); }
    __builtin_amdgcn_s_setprio(0);
    if (wave >= 4) SCAN_YOUT(yb1, NTILE - 1);
    __syncthreads();
#undef SCAN_TILE
#undef SCAN_YOUT
#undef SCAN_BAR
#undef SCAN_STAGE
#undef SCAN_S0
#undef SCAN_ISSUE
}

constexpr int KSTR = 72;
__device__ __forceinline__ void na_item(int item, const bf16* Z, const float* rpb, bf16* CC, LAS unsigned char* lds, int tid, int wave, int lane) {
    LAS bf16* Ks = (LAS bf16*)lds;
    LAS bf16* Vt = (LAS bf16*)(lds + 9216);
    LAS float* rp = (LAS float*)(lds + 18432);
    const int fr = lane & 15, g = lane >> 4;
    int b, h, is_ctx, qrow, ustart = 0, nloc = 0; size_t mq;
    if (item < 1536) { is_ctx = 0; b = item / 768; const int r = item % 768; h = r / 64; const int rpi = r % 64; const int ri0 = 2 * rpi;
        qrow = ri0 + (wave >> 2); ustart = min(max(ri0 - 4, 0), 120); nloc = min(max(ri0 + 1 - 4, 0), 120) + 8 - ustart;
        mq = (size_t)b * SEQ + qrow * 64 + (wave & 3) * 16 + fr; }
    else { is_ctx = 1; const int r = item - 1536; b = r / 24; h = (r % 24) >> 1; const int p = r & 1; qrow = 0;
        mq = (size_t)ML + b * CTXL + (2 * p + (wave >> 2)) * 64 + (wave & 3) * 16 + fr; }
    const int ci = (wave & 3) * 16 + fr;
    const int wstart = min(max(qrow - 4, 0), 120);
    const int cs = min(max(ci - 8, 0), 48);
    __syncthreads();
    if (!is_ctx) for (int i = tid; i < 465; i += NTHR) rp[i] = rpb[h * 465 + i];
    bf16x8 qf[2];
#pragma unroll
    for (int ks = 0; ks < 2; ++ks) qf[ks] = *(const bf16x8*)(Z + mq * INCP + ZC0 + h * 64 + 32 * ks + 8 * g);
    const int key = tid >> 3, ch = tid & 7;
    auto krow = [&](int t) -> size_t { return t < 9 ? (size_t)b * SEQ + (ustart + t) * 64 + key : (size_t)ML + b * CTXL + (t - 9) * 64 + key; };
    const int ntl = nloc + 4;
#define NA_TID(p) ((p) < nloc ? (p) : 9 + (p) - nloc)
#define NA_LOAD(kd, vd, p) do { const bf16* zp_ = Z + krow(NA_TID(p)) * INCP + ZC0 + h * 64 + ch * 8; kd = *(const u32x4*)(zp_ + 768); vd = *(const u32x4*)(zp_ + 1536); } while (0)
    u32x4 k0 = {0u, 0u, 0u, 0u}, v0 = k0, k1 = k0, v1 = k0, k2 = k0, v2 = k0;
    NA_LOAD(k0, v0, 0); NA_LOAD(k1, v1, 1); NA_LOAD(k2, v2, 2);
    int doff[4][4]; float madd[4][4];
#pragma unroll
    for (int nb = 0; nb < 4; ++nb)
#pragma unroll
        for (int e = 0; e < 4; ++e) { const int ck = nb * 16 + 4 * g + e; doff[nb][e] = min(max(ck - ci + 15, 0), 30); madd[nb][e] = ((ck >= cs) && (ck < cs + 16)) ? 0.f : -1e30f; }
    const int qblk = wave & 3, nlo = (qblk >= 2) ? qblk - 1 : 0, nhi = (qblk <= 1) ? qblk + 1 : 3;
    float mrun = -1e30f, lrun = 0.f;
    f32x4 oacc[4];
#pragma unroll
    for (int nb = 0; nb < 4; ++nb) oacc[nb] = (f32x4){0.f, 0.f, 0.f, 0.f};
    for (int p = 0; p < ntl; ++p) {
        const int t = NA_TID(p);
        __syncthreads();
        *(LAS u32x4*)(Ks + key * KSTR + ch * 8) = k0;
        { const unsigned w[4] = {v0.x, v0.y, v0.z, v0.w};
#pragma unroll
          for (int e = 0; e < 4; ++e) { Vt[(ch * 8 + 2 * e) * KSTR + key] = (bf16)(w[e] & 0xffffu); Vt[(ch * 8 + 2 * e + 1) * KSTR + key] = (bf16)(w[e] >> 16); } }
        __syncthreads();
        k0 = k1; v0 = v1; k1 = k2; v1 = v2;
        if (p + 3 < ntl) NA_LOAD(k2, v2, p + 3);
        const int br = ustart + t;
        const bool active = (t >= 9) || (br >= wstart && br < wstart + 8);
        if (active) {
            const bool loc = t < 9;
            f32x4 sc[4];
            float mt = -1e30f;
            const int dr31 = (br - qrow + 7) * 31;
#pragma unroll
            for (int nb = 0; nb < 4; ++nb) {
                const bool nbon = !loc || (nb >= nlo && nb <= nhi);
                sc[nb] = (f32x4){0.f, 0.f, 0.f, 0.f};
                if (nbon) {
#pragma unroll
                    for (int ks = 0; ks < 2; ++ks) { const bf16x8 kf = *(const LAS bf16x8*)(Ks + (nb * 16 + fr) * KSTR + 32 * ks + 8 * g); sc[nb] = MFMA16(kf, qf[ks], sc[nb]); }
                    if (loc) {
#pragma unroll
                        for (int e = 0; e < 4; ++e) { const float v = (sc[nb][e] * 0.125f + rp[dr31 + doff[nb][e]]) + madd[nb][e]; sc[nb][e] = v; mt = fmaxf(mt, v); }
                    } else {
#pragma unroll
                        for (int e = 0; e < 4; ++e) { const float v = sc[nb][e] * 0.125f; sc[nb][e] = v; mt = fmaxf(mt, v); }
                    }
                }
            }
            mt = fmaxf(mt, __shfl_xor(mt, 16)); mt = fmaxf(mt, __shfl_xor(mt, 32));
            const float mnew = fmaxf(mrun, mt), alpha = __expf(mrun - mnew); mrun = mnew;
            float ps = 0.f;
#pragma unroll
            for (int nb = 0; nb < 4; ++nb) {
                const bool nbon = !loc || (nb >= nlo && nb <= nhi);
                if (nbon) {
#pragma unroll
                    for (int e = 0; e < 4; ++e) { const float pp = __expf(sc[nb][e] - mnew); sc[nb][e] = pp; ps += pp; }
                } else sc[nb] = (f32x4){0.f, 0.f, 0.f, 0.f};
            }
            lrun = lrun * alpha + ps;
            bf16x8 pf[2];
#pragma unroll
            for (int ks = 0; ks < 2; ++ks) { u32x4 w; w.x = pk2(sc[2 * ks][0], sc[2 * ks][1]); w.y = pk2(sc[2 * ks][2], sc[2 * ks][3]); w.z = pk2(sc[2 * ks + 1][0], sc[2 * ks + 1][1]); w.w = pk2(sc[2 * ks + 1][2], sc[2 * ks + 1][3]);
                pf[ks] = __builtin_bit_cast(bf16x8, w); }
#pragma unroll
            for (int nb = 0; nb < 4; ++nb) oacc[nb] = oacc[nb] * alpha;
#pragma unroll
            for (int ks = 0; ks < 2; ++ks) {
                const bool kson = !loc || (2 * ks + 1 >= nlo && 2 * ks <= nhi);
                if (kson) {
#pragma unroll
                    for (int nb = 0; nb < 4; ++nb) { const LAS bf16* vp = Vt + (nb * 16 + fr) * KSTR + 32 * ks + 4 * g;
                        const u32x2 lo = *(const LAS u32x2*)vp, hi = *(const LAS u32x2*)(vp + 16);
                        u32x4 w; w.x = lo.x; w.y = lo.y; w.z = hi.x; w.w = hi.y;
                        oacc[nb] = MFMA16(__builtin_bit_cast(bf16x8, w), pf[ks], oacc[nb]); }
                }
            }
        }
    }
#undef NA_TID
#undef NA_LOAD
    lrun += __shfl_xor(lrun, 16); lrun += __shfl_xor(lrun, 32);
    const float il = 1.f / lrun;
    bf16* op = CC + mq * D + 1280 + h * 64 + 4 * g;
#pragma unroll
    for (int nb = 0; nb < 4; ++nb) { u32x2 w; w.x = pk2(oacc[nb][0] * il, oacc[nb][1] * il); w.y = pk2(oacc[nb][2] * il, oacc[nb][3] * il); *(u32x2*)(op + nb * 16) = w; }
}

constexpr int VSTR = 136;
__device__ __forceinline__ void gmlp_item(int item, const bf16* Z, const bf16* gmws, const float* gmbs, bf16* CC, LAS unsigned char* lds, int tid, int wave, int lane) {
    LAS bf16* vt = (LAS bf16*)lds;
    const int cidx = item >> 3, gi = item & 7, fr = lane & 15, g = lane >> 4;
    __syncthreads();
    { const int j = tid >> 2, part = tid & 3; const bf16* zp = Z + (size_t)(cidx * 128 + j) * INCP + 512 + gi * 64 + 16 * part;
      const u32x4 a = *(const u32x4*)zp, bq = *(const u32x4*)(zp + 8);
      float x[16]; const unsigned w[8] = {a.x, a.y, a.z, a.w, bq.x, bq.y, bq.z, bq.w};
      float s = 0.f;
#pragma unroll
      for (int e = 0; e < 8; ++e) { x[2 * e] = gelu_f(bflo(w[e])); x[2 * e + 1] = gelu_f(bfhi(w[e])); s += x[2 * e] + x[2 * e + 1]; }
      s += __shfl_xor(s, 1); s += __shfl_xor(s, 2); const float mu = s * (1.f / 64.f); float s2 = 0.f;
#pragma unroll
      for (int e = 0; e < 16; ++e) { x[e] -= mu; s2 += x[e] * x[e]; }
      s2 += __shfl_xor(s2, 1); s2 += __shfl_xor(s2, 2); const float rstd = rsqrtf(s2 * (1.f / 64.f) + LN_EPS);
#pragma unroll
      for (int e = 0; e < 16; ++e) vt[(16 * part + e) * VSTR + j] = (bf16)f2bf(x[e] * rstd); }
    __syncthreads();
    f32x4 acc[4];
#pragma unroll
    for (int nb = 0; nb < 4; ++nb) acc[nb] = (f32x4){0.f, 0.f, 0.f, 0.f};
    const int i = wave * 16 + fr;
#pragma unroll
    for (int ks = 0; ks < 4; ++ks) { const bf16x8 wf = *(const bf16x8*)(gmws + (size_t)(gi * 128 + i) * 128 + 32 * ks + 8 * g);
#pragma unroll
        for (int nb = 0; nb < 4; ++nb) { const bf16x8 vf = *(const LAS bf16x8*)(vt + (nb * 16 + fr) * VSTR + 32 * ks + 8 * g); acc[nb] = MFMA16(vf, wf, acc[nb]); } }
    const float bs = gmbs[gi * 128 + i];
    const size_t m = (size_t)cidx * 128 + i;
#pragma unroll
    for (int nb = 0; nb < 4; ++nb) { const int c = nb * 16 + 4 * g; const f32x4 u = bf4(*(const u32x2*)(Z + m * INCP + gi * 64 + c));
        u32x2 w; w.x = pk2(gelu_f(u.x) * (acc[nb][0] + bs), gelu_f(u.y) * (acc[nb][1] + bs)); w.y = pk2(gelu_f(u.z) * (acc[nb][2] + bs), gelu_f(u.w) * (acc[nb][3] + bs));
        *(u32x2*)(CC + m * D + gi * 64 + c) = w; }
}

__device__ __forceinline__ void rwkv_out_phase(int nrows, const bf16* Y, const bf16* G, const bf16* BV, const float* gng, const float* gnb, bf16* CC, int tid) {
    const int l16 = tid & 15;
    for (int gi = (blockIdx.x * NTHR + tid) >> 4; gi < nrows * NH; gi += (gridDim.x * NTHR) >> 4) {
        const int m = gi / NH, h = gi % NH; int b, s;
        if (m < ML) { b = m >> 13; s = CTXL + (m & 8191); } else { b = (m - ML) >> 8; s = (m - ML) & 255; }
        const int c = h * 64 + 4 * l16;
        const f32x4 y0 = bf4(*(const u32x2*)(Y + ((size_t)(b * SL + s)) * BW + c)), y1 = bf4(*(const u32x2*)(Y + ((size_t)((2 + b) * SL + s)) * BW + c));
        f32x4 y = y0 + y1;
        float sm = (y.x + y.y) + (y.z + y.w);
#pragma unroll
        for (int o = 1; o < 16; o <<= 1) sm += __shfl_xor(sm, o);
        const float mu = sm * (1.f / 64.f); y = y - mu;
        float s2 = (y.x * y.x + y.y * y.y) + (y.z * y.z + y.w * y.w);
#pragma unroll
        for (int o = 1; o < 16; o <<= 1) s2 += __shfl_xor(s2, o);
        const float rstd = rsqrtf(s2 * (1.f / 64.f) + GN_EPS);
        const f32x4 gg = *(const f32x4*)(gng + c), gb = *(const f32x4*)(gnb + c);
        const f32x4 bv = bf4(*(const u32x2*)(BV + (size_t)m * BW + c)), gt = bf4(*(const u32x2*)(G + (size_t)m * BW + c));
        const f32x4 o = (y * rstd * gg + gb + bv) * gt;
        u32x2 w; w.x = pk2(o.x, o.y); w.y = pk2(o.z, o.w);
        *(u32x2*)(CC + (size_t)m * D + 512 + c) = w;
    }
}

#ifndef PER_PHASE_LAUNCH
#define PER_PHASE_LAUNCH 0
#endif
#ifndef PH_MASK
#define PH_MASK 0x7ff
#endif
#define PHON(k) ((PH_MASK >> (k)) & 1)
#ifndef NA_EARLY
#define NA_EARLY 580
#endif
#ifndef WGM_N2048
#define WGM_N2048 4
#endif
#ifndef WGM_N8192
#define WGM_N8192 4
#endif
constexpr int N_PHASES = 21;
struct Args { In in; float* out; unsigned char* ws; int ph_lo, ph_hi; };
#define XB_TMO      128
#define XB_XCNT(j)  (256  + 64 * (j))
#define XB_XSUB(j)  (1280 + 64 * (j))
#define XB_XGEN(j)  (2304 + 64 * (j))
#define XB_TOP      3328
#define XB_TOPGEN   3392
#define XCD_BAR_WORDS 3456
#define XB_SPIN_CAP (1u << 18)

__device__ __forceinline__ unsigned xb_ld(unsigned* p)              { return __hip_atomic_load(p, __ATOMIC_RELAXED, __HIP_MEMORY_SCOPE_AGENT); }
__device__ __forceinline__ unsigned xb_add(unsigned* p, unsigned v) { return __hip_atomic_fetch_add(p, v, __ATOMIC_RELAXED, __HIP_MEMORY_SCOPE_AGENT); }
__device__ __forceinline__ unsigned xb_xcc_id() { return (unsigned)__builtin_amdgcn_s_getreg((3 << 11) | 20) & 0xFu; }
#define XB_SPIN(cond, bar) do { unsigned _sp = 0; while (cond) { __builtin_amdgcn_s_sleep(1); \
    if ((++_sp & 255u) == 0u) { if (xb_ld(&(bar)[XB_TMO])) break; if (_sp > XB_SPIN_CAP) { atomicAdd(&(bar)[XB_TMO], 1u); break; } } } } while (0)

struct XcdBarrier {
    unsigned* bar; unsigned x;
    volatile LAS unsigned* st;
};

__device__ __forceinline__ XcdBarrier xcd_barrier_post(unsigned* bar, volatile LAS unsigned* st) {
    XcdBarrier b; b.bar = bar; b.x = xb_xcc_id(); b.st = st;
    if (threadIdx.x == 0) (void)xb_add(&bar[XB_XCNT(b.x)], 1u);
    return b;
}
__device__ __forceinline__ void xcd_barrier_complete(unsigned* bar, unsigned x, unsigned& nloc, unsigned& nx) {
    const unsigned G = gridDim.x * gridDim.y * gridDim.z;
    unsigned sum, cnt, mine, sp = 0u;
    for (;;) {
        sum = 0u; cnt = 0u; mine = 0u;
#pragma unroll
        for (unsigned j = 0; j < 16; ++j) { const unsigned c = xb_ld(&bar[XB_XCNT(j)]); sum += c; cnt += (c > 0u) ? 1u : 0u; mine = (j == x) ? c : mine; }
        if (sum == G) break;
        __builtin_amdgcn_s_sleep(1);
        if ((++sp & 255u) == 0u) { if (xb_ld(&bar[XB_TMO])) break; if (sp > XB_SPIN_CAP) { atomicAdd(&bar[XB_TMO], 1u); break; } }
    }
    nloc = mine > 0u ? mine : 1u; nx = cnt > 0u ? cnt : 1u;
}

__device__ __forceinline__ void xcd_barrier(const XcdBarrier& b) {
    asm volatile("s_waitcnt vmcnt(0)" ::: "memory");
    __syncthreads();
    if (threadIdx.x == 0) {
        unsigned* bar = b.bar;
        __builtin_amdgcn_s_waitcnt(0);
        unsigned nloc = b.st[0], nx = b.st[1];
        if (nloc == 0u) { xcd_barrier_complete(bar, b.x, nloc, nx); b.st[0] = nloc; b.st[1] = nx; }
        const unsigned old = xb_add(&bar[XB_XSUB(b.x)], 1u);
        const unsigned gen = old / nloc;
        if (old + 1u == (gen + 1u) * nloc) {
            __builtin_amdgcn_fence(__ATOMIC_RELEASE, "agent");
            asm volatile("s_waitcnt vmcnt(0)" ::: "memory");
            const unsigned og = xb_add(&bar[XB_TOP], 1u);
            const unsigned tg = og / nx;
            if (og + 1u == (tg + 1u) * nx) xb_add(&bar[XB_TOPGEN], 1u);
            else XB_SPIN(xb_ld(&bar[XB_TOPGEN]) == tg, bar);
            __builtin_amdgcn_fence(__ATOMIC_ACQUIRE, "agent");
            xb_add(&bar[XB_XGEN(b.x)], 1u);
            asm volatile("s_waitcnt vmcnt(0)" ::: "memory");
        } else {
            XB_SPIN(xb_ld(&bar[XB_XGEN(b.x)]) == gen, bar);
            __builtin_amdgcn_fence(__ATOMIC_ACQUIRE, "agent");
            asm volatile("s_waitcnt vmcnt(0)" ::: "memory");
        }
    }
    __syncthreads();
}

constexpr size_t WS_BAR = WS_CTL + 320 * 1024;
constexpr int LDS_BARW = LDS_BYTES - 64;

template <int PH> __device__ __forceinline__ void run_phase(const Args& args, LAS unsigned char* lds, int part = 3) {
    const int tid = threadIdx.x, lane = tid & 63, wave = __builtin_amdgcn_readfirstlane(tid >> 6);
    const int gw = blockIdx.x * NWAVES + wave, NGW = gridDim.x * NWAVES;
    const In& in = args.in;
    unsigned char* ws = args.ws;
    float* mod = (float*)(ws + WS_CTL);
    bf16* small = (bf16*)(ws + WS_SMALL);
    float* XC = (float*)(ws + WS_XC); float* XL = args.out;
    bf16* AC = (bf16*)(ws + WS_AC); bf16* Z = (bf16*)(ws + WS_Z);
    if constexpr (PH == 0) {
        if (PHON(10)) { mod_gemv(in, mod, gw, NGW, lane); convert_weights(in, 0, 0, ws, lds, gw, NGW, wave, lane); }
    } else {
        constexpr int l = (PH - 1) / 10, sub = (PH - 1) % 10;
        const float* modl = mod + (size_t)l * 3 * NMOD;
        constexpr int Mrows = (l == 0) ? MT : ML;
        if constexpr (sub == 0) {
            if (l == 0 && PHON(0)) rowwise(gw, NGW, lane, MT, in.p[0], in.p[2], XL, XC, false, in.p[22], in.p[23], true, modl, 0, 1, AC);
        } else if constexpr (sub == 1) { if (PHON(1)) {
            pg8::Gemm g{AC, (bf16*)(ws + WS_WIN), ML, INCP, D}; pg8::StaticOrder S; S.init(ML, INCP, (int)gridDim.x, (int)blockIdx.x);
            EpiStoreBf16<0> E{Z, INCP};
            pg8::gemm_phase<EpiStoreBf16<0>, pg8::StaticOrder, true, true>(lds, g, S, E); }
        } else if constexpr (sub == 2) { if (PHON(2)) {
            rwkv_proj_phase(Z, in.p[9] + (size_t)l * 3 * BCOLS, in.p[10] + (size_t)l * 2 * BW, in.p[12] + (size_t)l * 2 * BW, in.p[15] + (size_t)l * BW, in.p[16] + (size_t)l * BW,
                            in.p[17] + (size_t)l * BW, small + SM_W2T, small + SM_A2T, small + SM_G2T, (bf16*)(ws + WS_SOP), (bf16*)(ws + WS_G), (bf16*)(ws + WS_BV), lds, tid, wave, lane);
            if ((int)blockIdx.x >= 140) for (int it = (int)blockIdx.x - 140; it < NA_EARLY; it += (int)gridDim.x - 140) na_item(it, Z, in.p[20] + (size_t)l * NH * 465, AC, lds, tid, wave, lane); }
        } else if constexpr (sub == 3) { if (PHON(3)) {
            if ((int)blockIdx.x < SCAN_BLOCKS) { if (part & 1) {
                const int blk = blockIdx.x, x = blk & 7, slot = blk >> 3, pair = x + 8 * (slot / BPH), quarter = slot % BPH;
                scan_block(pair, quarter, (const bf16*)(ws + WS_SOP), (bf16*)(ws + WS_Y), lds, tid, wave, lane, part); }
            } else if (part & 2) {
                constexpr int nNA = (l == 0) ? 1584 : 1536, nG = (l == 0) ? 1056 : 1024;
                for (int it = NA_EARLY + (int)blockIdx.x - SCAN_BLOCKS; it < nNA + nG; it += (int)gridDim.x - SCAN_BLOCKS) {
                    if (it < nNA) na_item(it, Z, in.p[20] + (size_t)l * NH * 465, AC, lds, tid, wave, lane);
                    else gmlp_item(it - nNA, Z, small + SM_GMWS, in.p[8] + (size_t)l * 1024, AC, lds, tid, wave, lane);
                }
                __syncthreads();
                convert_weights(in, l, 1, ws, lds, ((int)blockIdx.x - SCAN_BLOCKS) * NWAVES + wave, ((int)gridDim.x - SCAN_BLOCKS) * NWAVES, wave, lane);
            } }
        } else if constexpr (sub == 4) { if (PHON(4)) {
            rwkv_out_phase(Mrows, (const bf16*)(ws + WS_Y), (const bf16*)(ws + WS_G), (const bf16*)(ws + WS_BV), in.p[18] + (size_t)l * BW, in.p[19] + (size_t)l * BW, AC, tid); }
        } else if constexpr (sub == 5) { if (PHON(5)) {
            pg8::Gemm g{AC, (bf16*)(ws + WS_WOUT), ML, D, D}; pg8::StaticOrder S; S.init(ML, D, (int)gridDim.x, (int)blockIdx.x, WGM_N2048);
            EpiRes E{(l == 0) ? in.p[0] : (const float*)XL, (l == 0) ? in.p[2] : (const float*)XC, XL, XC, modl + 2 * D};
            pg8::gemm_phase<EpiRes, pg8::StaticOrder, true, true>(lds, g, S, E); }
        } else if constexpr (sub == 6) { if (PHON(6)) {
            rowwise(gw, NGW, lane, Mrows, XL, (l == 0) ? in.p[2] : (const float*)XC, XL, XC, true, in.p[22] + (size_t)l * D, in.p[23] + (size_t)l * D, true, modl, 3, 4, AC, (const float*)(ws + WS_SLAB), (l == 0) ? 8 : 0); }
        } else if constexpr (sub == 7) { if (PHON(7)) {
            pg8::Gemm g{AC, (bf16*)(ws + WS_WUP), Mrows, DFF, D}; pg8::StaticOrder S; S.init(Mrows, DFF, (int)gridDim.x, (int)blockIdx.x, WGM_N8192);
            EpiStoreBf16<1> E{(bf16*)(ws + WS_HM), DFF};
            pg8::gemm_phase<EpiStoreBf16<1>, pg8::StaticOrder, true, true>(lds, g, S, E); }
        } else if constexpr (sub == 8) { if (PHON(8)) {
            pg8::Gemm g{(bf16*)(ws + WS_HM), (bf16*)(ws + WS_WDN), ML, D, DFF}; pg8::StaticOrder S; S.init(ML, D, (int)gridDim.x, (int)blockIdx.x, WGM_N2048);
            EpiRes E{XL, XC, XL, XC, modl + 5 * D};
            pg8::gemm_phase<EpiRes, pg8::StaticOrder, true, true>(lds, g, S, E); }
        } else { if (PHON(9)) {
            rowwise(gw, NGW, lane, Mrows, XL, XC, XL, XC, true, in.p[26] + (size_t)l * D, in.p[27] + (size_t)l * D, l == 0, modl + 3 * NMOD, 0, 1, AC, (const float*)(ws + WS_SLAB), (l == 0) ? 16 : 0);
            if (l == 0) { __syncthreads(); convert_weights(in, 1, 0, ws, lds, gw, NGW, wave, lane); } }
        }
    }
}
template <int PH> __device__ __forceinline__ void run_ctx(const Args& args, LAS unsigned char* lds) {
    unsigned char* ws = args.ws;
    if constexpr (PH == 6 || PH == 9) {
        const float* modl = (const float*)(ws + WS_CTL);
        const int KS = (PH == 6) ? 256 : 512, LDK = (PH == 6) ? D : DFF, NS = (PH == 6) ? 8 : 16;
        const bf16* A = (PH == 6) ? (const bf16*)(ws + WS_AC) + (size_t)ML * D : (const bf16*)(ws + WS_HM) + (size_t)ML * DFF;
        const bf16* W = (PH == 6) ? (const bf16*)(ws + WS_WOUT) : (const bf16*)(ws + WS_WDN);
        pg8::Gemm g2{A, W, 2 * CTXL, D, KS, LDK}; SplitKOrder S2{2, 8, NS, (int)gridDim.x, (int)blockIdx.x};
        EpiSlabCtx E2{(float*)(ws + WS_SLAB), modl + 2 * NMOD + ((PH == 6) ? 2 : 5) * D, D};
        pg8::gemm_phase<EpiSlabCtx, SplitKOrder, true, true>(lds, g2, S2, E2);
    } else if constexpr (PH == 2 || PH == 12) {
        pg8::Gemm g2{(const bf16*)(ws + WS_AC) + (size_t)ML * D, (const bf16*)(ws + WS_WIN), 2 * CTXL, INCP, 512, D}; SplitKOrder S2{2, 24, 4, (int)gridDim.x, (int)blockIdx.x};
        EpiSlabCtx E2{(float*)(ws + WS_SLAB), nullptr, INCP};
        pg8::gemm_phase<EpiSlabCtx, SplitKOrder, true, true>(lds, g2, S2, E2);
    }
}
__device__ __forceinline__ void hctx_sum(const Args& args) {
    const float* slab = (const float*)(args.ws + WS_SLAB); bf16* H = (bf16*)(args.ws + WS_HM) + (size_t)ML * DFF;
    constexpr int NG = 2 * CTXL * DFF / 4; constexpr size_t SS = (size_t)2 * CTXL * DFF;
    for (int i = blockIdx.x * NTHR + threadIdx.x; i < NG; i += gridDim.x * NTHR) {
        f32x4 v = (*(const f32x4*)(slab + 4 * (size_t)i) + *(const f32x4*)(slab + SS + 4 * (size_t)i)) + (*(const f32x4*)(slab + 2 * SS + 4 * (size_t)i) + *(const f32x4*)(slab + 3 * SS + 4 * (size_t)i));
        v.x = fmaxf(v.x, 0.f); v.y = fmaxf(v.y, 0.f); v.z = fmaxf(v.z, 0.f); v.w = fmaxf(v.w, 0.f); v = v * v;
        u32x2 o; o.x = pk2(v.x, v.y); o.y = pk2(v.z, v.w); *(u32x2*)(H + 4 * (size_t)i) = o; }
}
__device__ __forceinline__ void zctx_sum(const Args& args) {
    const float* slab = (const float*)(args.ws + WS_SLAB); bf16* Z = (bf16*)(args.ws + WS_Z) + (size_t)ML * INCP;
    constexpr int NG = 2 * CTXL * INCP / 4; constexpr size_t SS = (size_t)2 * CTXL * INCP;
    for (int i = blockIdx.x * NTHR + threadIdx.x; i < NG; i += gridDim.x * NTHR) {
        const f32x4 v = (*(const f32x4*)(slab + 4 * (size_t)i) + *(const f32x4*)(slab + SS + 4 * (size_t)i)) + (*(const f32x4*)(slab + 2 * SS + 4 * (size_t)i) + *(const f32x4*)(slab + 3 * SS + 4 * (size_t)i));
        u32x2 o; o.x = pk2(v.x, v.y); o.y = pk2(v.z, v.w); *(u32x2*)(Z + 4 * (size_t)i) = o; }
}
__global__ void __launch_bounds__(NTHR, 2) fwd_megakernel(Args args) {
    extern __shared__ __attribute__((aligned(16))) unsigned char lds_raw[];
    LAS unsigned char* lds = (LAS unsigned char*)lds_raw;
    cg::grid_group grid = cg::this_grid();
    const int lo = args.ph_lo, hi = args.ph_hi;
    if (threadIdx.x < 16) ((LAS unsigned*)(lds + LDS_BARW))[threadIdx.x] = 0u;
    __syncthreads();
    const XcdBarrier xbar = xcd_barrier_post((unsigned*)(args.ws + WS_BAR), (volatile LAS unsigned*)(lds + LDS_BARW));
#define GRID_SYNC(PH) do { if ((PH) == 0) grid.sync(); else xcd_barrier(xbar); } while (0)
#ifndef REP_PART
#define REP_PART 3
#endif
#ifndef REP_MASK
#define REP_MASK 0
#endif
#define REPON(PH) ((PH) > 0 && ((REP_MASK >> (((PH) - 1) % 10)) & 1))
#define DO(PH) if (lo <= (PH) && (PH) < hi) { if (REPON(PH)) { if (REP_PART != 64) run_phase<PH>(args, lds, REP_PART); if ((PH) == 0) grid.sync(); else xcd_barrier(xbar); } run_phase<PH>(args, lds); run_ctx<PH>(args, lds); if ((PH) == 2 || (PH) == 12) { xcd_barrier(xbar); zctx_sum(args); } if ((PH) + 1 < hi) GRID_SYNC(PH); }
    DO(0) DO(1) DO(2) DO(3) DO(4) DO(5) DO(6) DO(7) DO(8) DO(9) DO(10)
    DO(11) DO(12) DO(13) DO(14) DO(15) DO(16) DO(17) DO(18) DO(19) DO(20)
#undef DO
}

extern "C" void kernel_launch(void* const* d_in, const int* in_sizes, int n_in, void* d_out, int out_size, void* d_ws, size_t ws_size, hipStream_t stream) {
    static int grid = 0;
    if (grid == 0) {
        if (n_in != 28 || ws_size < WS_END) { fprintf(stderr, "kernel_launch: unexpected n_in %d / ws_size %zu (need %zu)\n", n_in, ws_size, (size_t)WS_END); grid = -1; return; }
        int dev = 0, cus = 0;
        if (hipGetDevice(&dev) != hipSuccess || hipDeviceGetAttribute(&cus, hipDeviceAttributeMultiprocessorCount, dev) != hipSuccess) { grid = -1; return; }
        if (hipFuncSetAttribute((const void*)fwd_megakernel, hipFuncAttributeMaxDynamicSharedMemorySize, LDS_BYTES) != hipSuccess) { fprintf(stderr, "kernel_launch: hipFuncSetAttribute failed\n"); grid = -1; return; }
        grid = cus;
    }
    if (grid < 0) return;
    (void)hipMemsetAsync((char*)d_ws + WS_CTL, 0, CTL_BYTES, stream);
    Args a{};
    for (int i = 0; i < 28; ++i) a.in.p[i] = (const float*)d_in[i];
    a.out = (float*)d_out; a.ws = (unsigned char*)d_ws;
#if PER_PHASE_LAUNCH
    for (int ph = 0; ph < N_PHASES; ++ph) { a.ph_lo = ph; a.ph_hi = ph + 1; hipLaunchKernelGGL(fwd_megakernel, dim3(grid), dim3(NTHR), LDS_BYTES, stream, a); }
#else
    a.ph_lo = 0; a.ph_hi = N_PHASES;
    void* kargs[] = {&a};
    hipError_t e = hipLaunchCooperativeKernel((const void*)fwd_megakernel, dim3(grid), dim3(NTHR), kargs, LDS_BYTES, stream);
    if (e != hipSuccess) fprintf(stderr, "cooperative launch failed: %s (grid %d)\n", hipGetErrorString(e), grid);
#endif
}
```
